# Optimizing an MI355X kernel written in HIP

```python
import jax, jax.numpy as jnp
from jax import lax
import numpy as np

D_MODEL = 1024
BATCH = 16
SEQ = 2048
DEPTH = 2

CHUNK = 64
N_MIXERS = 2
EXPAND = 2
D_INNER = EXPAND * D_MODEL
SG_BLOCK = 128
SG_GROUPS = 8
SG_GROUP_DIM = D_INNER // SG_GROUPS
HG_HEADS = 16
HG_HEAD_DIM = D_INNER // HG_HEADS
N_LAYERS_A = (DEPTH + 1) // 2
N_LAYERS_B = DEPTH // 2
EPS = 1e-6

kernel_name = "hybrid_gmlp_hgrn2_adaln_trunk"


def rms_norm(x, gain):
    xf = x.astype(jnp.float32)
    y = xf * lax.rsqrt(jnp.mean(xf * xf, axis=-1, keepdims=True) + EPS)
    return (y * gain.astype(jnp.float32)).astype(x.dtype)


def layer_norm(x, gain, bias):
    xf = x.astype(jnp.float32)
    mu = jnp.mean(xf, axis=-1, keepdims=True)
    var = jnp.mean(jnp.square(xf - mu), axis=-1, keepdims=True)
    y = (xf - mu) * lax.rsqrt(var + EPS) * gain.astype(jnp.float32) + bias.astype(jnp.float32)
    return y.astype(x.dtype)


def spatial_gating_mixer(h, w_in, ln_gain, ln_bias, w_s, b_s, w_out):
    bsz, seq, _ = h.shape
    proj = h @ w_in
    uv, g = proj[..., : 2 * D_INNER], proj[..., 2 * D_INNER:]
    uv = jax.nn.gelu(uv)
    u, v = uv[..., :D_INNER], uv[..., D_INNER:]
    v = layer_norm(v, ln_gain, ln_bias)
    nb = seq // SG_BLOCK
    v = v.reshape(bsz, nb, SG_BLOCK, SG_GROUPS, SG_GROUP_DIM)
    pos = jnp.arange(SG_BLOCK)
    mask = (pos[None, :] // CHUNK) <= (pos[:, None] // CHUNK)
    ws = jnp.where(mask[None], w_s, jnp.zeros((), w_s.dtype))
    s = jnp.einsum('gts,bnsgd->bntgd', ws, v) + b_s.T[None, None, :, :, None]
    s = s.reshape(bsz, seq, D_INNER)
    y = u * s * jax.nn.silu(g)
    return y @ w_out


def hgrn2_mixer(h, w_in, lower_bound, gn_gain, w_out):
    bsz, seq, _ = h.shape
    f32 = jnp.float32
    proj = h @ w_in
    q = proj[..., :D_INNER]
    f = proj[..., D_INNER: 2 * D_INNER]
    i = proj[..., 2 * D_INNER: 3 * D_INNER]
    g = proj[..., 3 * D_INNER:]
    q = jax.nn.silu(q.astype(f32))
    lb = lower_bound.astype(f32)
    f = lb + (1.0 - lb) * jax.nn.sigmoid(f.astype(f32))
    k = 1.0 - f
    log_f = jnp.log(f)
    nc = seq // CHUNK

    def heads(z):
        return z.reshape(bsz, nc, CHUNK, HG_HEADS, HG_HEAD_DIM).transpose(0, 3, 1, 2, 4)

    q, k, v, log_f = heads(q), heads(k), heads(i.astype(f32)), heads(log_f)
    a = jnp.cumsum(log_f, axis=3)
    a_ref = a[:, :, :, CHUNK // 2 - 1: CHUNK // 2, :]
    a_last = a[:, :, :, CHUNK - 1:, :]
    q_in = q * jnp.exp(a - a_ref)
    k_in = k * jnp.exp(a_ref - a)
    scores = jnp.einsum('bhnck,bhnsk->bhncs', q_in, k_in)
    causal = jnp.tril(jnp.ones((CHUNK, CHUNK), dtype=bool))
    scores = jnp.where(causal, scores, jnp.zeros((), f32))
    o_intra = jnp.einsum('bhncs,bhnsv->bhncv', scores, v)
    q_out = q * jnp.exp(a)
    k_out = k * jnp.exp(a_last - a)
    decay = jnp.exp(a_last[:, :, :, 0, :])

    def step(state, xs):
        q_c, k_c, v_c, d_c = xs
        o_c = jnp.einsum('bhck,bhkv->bhcv', q_c, state)
        state = d_c[..., None] * state + jnp.einsum('bhck,bhcv->bhkv', k_c, v_c)
        return state, o_c

    xs = (jnp.moveaxis(q_out, 2, 0), jnp.moveaxis(k_out, 2, 0),
          jnp.moveaxis(v, 2, 0), jnp.moveaxis(decay, 2, 0))
    init = jnp.zeros((bsz, HG_HEADS, HG_HEAD_DIM, HG_HEAD_DIM), f32)
    _, o_inter = lax.scan(step, init, xs)
    o = o_intra + jnp.moveaxis(o_inter, 0, 2)
    o = o.transpose(0, 2, 3, 1, 4)
    o = rms_norm(o, gn_gain)
    o = o.reshape(bsz, seq, D_INNER).astype(h.dtype)
    return (o * jax.nn.silu(g)) @ w_out


def setup_inputs(seed: int = 0) -> dict:
    key = jax.random.key(seed)
    ks = jax.random.split(key, 20)
    nrm = jax.random.normal
    f32 = jnp.float32
    D, DI = D_MODEL, D_INNER
    return {
        "x": nrm(ks[0], (BATCH, SEQ, D), f32),
        "c": nrm(ks[1], (BATCH, D), f32),
        "norm_gain": 1.0 + 0.02 * nrm(ks[2], (DEPTH, D), f32),
        "w_ada": 0.5 * D ** -0.5 * nrm(ks[3], (DEPTH, D, 3 * D), f32),
        "b_ada": 0.02 * nrm(ks[4], (DEPTH, 3 * D), f32),
        "a_w_in": D ** -0.5 * nrm(ks[5], (N_LAYERS_A, D, 3 * DI), f32),
        "a_ln_gain": 1.0 + 0.02 * nrm(ks[6], (N_LAYERS_A, DI), f32),
        "a_ln_bias": 0.02 * nrm(ks[7], (N_LAYERS_A, DI), f32),
        "a_w_s": SG_BLOCK ** -0.5 * nrm(ks[8], (N_LAYERS_A, SG_GROUPS, SG_BLOCK, SG_BLOCK), f32),
        "a_b_s": 1.0 + 0.02 * nrm(ks[9], (N_LAYERS_A, SG_GROUPS, SG_BLOCK), f32),
        "a_w_out": DI ** -0.5 * nrm(ks[10], (N_LAYERS_A, DI, D), f32),
        "b_w_in": D ** -0.5 * nrm(ks[11], (N_LAYERS_B, D, 4 * DI), f32),
        "b_lower_bounds": 0.1 * nrm(ks[12], (DEPTH, DI), f32),
        "b_gn_gain": 1.0 + 0.02 * nrm(ks[13], (N_LAYERS_B, HG_HEAD_DIM), f32),
        "b_w_out": DI ** -0.5 * nrm(ks[14], (N_LAYERS_B, DI, D), f32),
        "final_gain": 1.0 + 0.02 * nrm(ks[15], (D,), f32),
    }


def reference(x, c, norm_gain, w_ada, b_ada, a_w_in, a_ln_gain, a_ln_bias, a_w_s, a_b_s,
              a_w_out, b_w_in, b_lower_bounds, b_gn_gain, b_w_out, final_gain):
    p = jax.nn.softmax(b_lower_bounds.astype(jnp.float32), axis=0)
    cum = jnp.cumsum(p, axis=0)
    lower_bounds = cum - cum[0:1]
    c_act = jax.nn.silu(c)
    for layer in range(DEPTH):
        mod = c_act @ w_ada[layer] + b_ada[layer]
        shift = mod[:, None, :D_MODEL]
        scale = mod[:, None, D_MODEL: 2 * D_MODEL]
        gate = mod[:, None, 2 * D_MODEL:]
        h = rms_norm(x, norm_gain[layer]) * (1.0 + scale) + shift
        j = layer // N_MIXERS
        if layer % N_MIXERS == 0:
            y = spatial_gating_mixer(h, a_w_in[j], a_ln_gain[j], a_ln_bias[j],
                                     a_w_s[j], a_b_s[j], a_w_out[j])
        else:
            y = hgrn2_mixer(h, b_w_in[j], lower_bounds[layer], b_gn_gain[j], b_w_out[j])
        x = x + gate * y
    return rms_norm(x, final_gain)
```

```cpp
#include <hip/hip_runtime.h>
#include <hip/hip_cooperative_groups.h>
#include <cstdio>
namespace cg = cooperative_groups;
#ifndef ONLY_PHASE
#define ONLY_PHASE -1
#endif
#define PHEN(k) (ONLY_PHASE < 0 || ONLY_PHASE == (k))
#ifndef ONE_LAUNCH
#define ONE_LAUNCH 0
#endif
namespace pg8 {
#define PG8_LAS __attribute__((address_space(3)))
typedef unsigned short bf16_t;
typedef short bf16x8 __attribute__((ext_vector_type(8)));
typedef float f32x4 __attribute__((ext_vector_type(4)));
typedef unsigned u32x4 __attribute__((ext_vector_type(4)));
constexpr int BM = 256, BK = 64, HALF = 128, HTB = HALF * BK * 2  , STAGE_BYTES = 8 * HTB, NXCD = 8, WGM = 8;

__host__ __device__ __forceinline__ int lds_byte(int r, int c) { const int st = (r >> 4) * 2 + (c >> 5), rr = r & 15, cc = c & 31, ob = rr * 64 + cc * 2; return st * 1024 + (ob ^ (((ob >> 9) & 1) << 5)); }
__host__ __device__ __forceinline__ void stage_rc(int b, int& R, int& C) { const int st = b / 1024, sb = b % 1024, swz = sb ^ (((sb >> 9) & 1) << 5); R = (st >> 1) * 16 + swz / 64; C = (st & 1) * 32 + (swz % 64) / 2; }
__host__ __device__ __forceinline__ int perm32(int rho) { const int n = rho >> 4, i = rho & 15; return 8 * (i >> 2) + 4 * n + (i & 3); }

struct Unit { int pm, pn; };
struct Gemm { const bf16_t* A; const bf16_t* Bt; int M, N, K; };

struct StaticOrder {
    int nM, nN, nwg, G, c;
    __host__ __device__ void init(int M, int N, int G_, int c_) { nM = M / BM; nN = N / BM; nwg = nM * nN; G = G_; c = c_; }
    __host__ __device__ bool next(int i, Unit& u) const {
        const long L = (long)i * G + c; if (L >= nwg) return false;
        int wgid = (int)L; { const int q = nwg / NXCD, r = nwg % NXCD, xcd = wgid % NXCD, off = wgid / NXCD; wgid = (xcd < r ? xcd * (q + 1) : r * (q + 1) + (xcd - r) * q) + off; }
        const int nig = WGM * nN, gid = wgid / nig, fm = gid * WGM, gsz = (nM - fm) < WGM ? (nM - fm) : WGM;
        u.pm = fm + ((wgid % nig) % gsz); u.pn = (wgid % nig) / gsz; return true;
    }
    __device__ __forceinline__ void a_ready(const Unit&) const {}
    __device__ __forceinline__ void done(const Unit&) const {}
};
__device__ __forceinline__ unsigned cvt_pk_bf16(float lo, float hi) { unsigned r; asm volatile("v_cvt_pk_bf16_f32 %0, %1, %2" : "=v"(r) : "v"(lo), "v"(hi)); return r; }
typedef float f32x2 __attribute__((ext_vector_type(2)));
template <class Epi, class Sched, bool STAMP = false>
__device__ __forceinline__ void gemm_phase(PG8_LAS unsigned char* lds, const Gemm g, const Sched& S, const Epi& E, unsigned long long* stamps) {
    const int tid = threadIdx.x, wid = __builtin_amdgcn_readfirstlane(tid >> 6), lane = tid & 63, wr = wid >> 2, wc = wid & 3, fr = lane & 15, fq = lane >> 4;
    const int K = g.K, nt = K / BK;
    int ts_lo = 0, ts_hi = 0, nts = 0; const unsigned long long rt_entry = STAMP ? (unsigned long long)wall_clock64() : 0ull;
#define PG8_STAMP() do { if (STAMP && wid == 0 && nts < 64) { const unsigned long long _c = (unsigned long long)clock64(); \
        ts_lo = (lane == nts) ? (int)(unsigned)_c : ts_lo; ts_hi = (lane == nts) ? (int)(unsigned)(_c >> 32) : ts_hi; ++nts; } } while (0)
    PG8_STAMP();
    unsigned voffA[2], voffB[2];
#pragma unroll
    for (int i = 0; i < 2; ++i) { int R, C; stage_rc(tid * 16 + i * 8192, R, C); const int Rb = Epi::PERM ? ((R & ~31) + perm32(R & 31)) : R;
        voffA[i] = (unsigned)(R * K + C) * 2u; voffB[i] = (unsigned)(Rb * K + C) * 2u; }
    const size_t kstep = (size_t)(BK * 2);
    const size_t hstep = (size_t)HALF * K * 2;
    const size_t tstep = 2 * hstep;
    const unsigned ldsw = (unsigned)wid * 1024u;
    const int aoff = lds_byte(wr * 64 + fr, fq * 8), boff = lds_byte(wc * 32 + fr, fq * 8);
#define PG8_SA(b, h) (((b) * 2 + (h)) * HTB)
#define PG8_SB(b, h) ((4 + (b) * 2 + (h)) * HTB)
#define PG8_STAGE(bufoff, gbase, voff) do { _Pragma("unroll") for (int _i = 0; _i < 2; ++_i) \
        __builtin_amdgcn_global_load_lds((const unsigned*)((const char*)(gbase) + (voff)[_i]), (PG8_LAS unsigned*)(lds + (bufoff) + ldsw + _i * 8192), 16, 0, 0); } while (0)
#define PG8_LDA(dst, b, h) do { _Pragma("unroll") for (int m = 0; m < 4; ++m) _Pragma("unroll") for (int k = 0; k < 2; ++k) dst[m][k] = *(const PG8_LAS bf16x8*)(lds + PG8_SA(b, h) + aoff + m * 2048 + k * 1024); } while (0)
#define PG8_LDB(dst, b, h) do { _Pragma("unroll") for (int n = 0; n < 2; ++n) _Pragma("unroll") for (int k = 0; k < 2; ++k) dst[n][k] = *(const PG8_LAS bf16x8*)(lds + PG8_SB(b, h) + boff + n * 2048 + k * 1024); } while (0)
#define PG8_MMA(ai, bj, At, Bt) do { __builtin_amdgcn_s_setprio(1); _Pragma("unroll") for (int m = 0; m < 4; ++m) _Pragma("unroll") for (int n = 0; n < 2; ++n) _Pragma("unroll") for (int k = 0; k < 2; ++k) \
        acc[ai][bj][m][n] = __builtin_amdgcn_mfma_f32_16x16x32_bf16(Bt[n][k], At[m][k], acc[ai][bj][m][n], 0, 0, 0); __builtin_amdgcn_s_setprio(0); } while (0)
#define PG8_WAIT_V(n) asm volatile("s_waitcnt vmcnt(" #n ")" ::: "memory")
#define PG8_WAIT_L(n) asm volatile("s_waitcnt lgkmcnt(" #n ")" ::: "memory")
#define PG8_BAR __builtin_amdgcn_s_barrier()
#define PG8_SCHED __builtin_amdgcn_sched_barrier(0)
    Unit cur, nxt; int ui = 0;
    if (!S.next(0, cur)) return;
    f32x4 acc[2][2][4][2];
#pragma unroll
    for (int a = 0; a < 2; ++a)
#pragma unroll
        for (int b = 0; b < 2; ++b)
#pragma unroll
            for (int m = 0; m < 4; ++m)
#pragma unroll
                for (int n = 0; n < 2; ++n) acc[a][b][m][n] = (f32x4){0.f, 0.f, 0.f, 0.f};
    bf16x8 At[4][2], B0[2][2], B1[2][2];
    const char* cA = (const char*)g.A + (size_t)cur.pm * tstep; const char* cB = (const char*)g.Bt + (size_t)cur.pn * tstep;
    S.a_ready(cur);
    PG8_STAGE(PG8_SB(0, 0), cB, voffB); PG8_STAGE(PG8_SA(0, 0), cA, voffA); PG8_STAGE(PG8_SB(0, 1), cB + hstep, voffB); PG8_STAGE(PG8_SA(0, 1), cA + hstep, voffA);
    if (wr == 1) PG8_BAR;
    PG8_WAIT_V(4); PG8_BAR;
    PG8_STAGE(PG8_SB(1, 0), cB + kstep, voffB); PG8_STAGE(PG8_SA(1, 0), cA + kstep, voffA); PG8_STAGE(PG8_SB(1, 1), cB + hstep + kstep, voffB);
    PG8_WAIT_V(6); PG8_BAR;
    PG8_STAMP();
    for (;;) {
        const bool has_next = S.next(ui + 1, nxt);
        const char* nA = has_next ? (const char*)g.A + (size_t)nxt.pm * tstep : cA; const char* nB = has_next ? (const char*)g.Bt + (size_t)nxt.pn * tstep : cB;
        for (int t = 0; t < nt; t += 2) {
            const bool last = (t == nt - 2);
            const char* a1 = cA + (size_t)(t + 1) * kstep;
            const char* a2 = last ? nA : cA + (size_t)(t + 2) * kstep; const char* b2 = last ? nB : cB + (size_t)(t + 2) * kstep;
            const char* a3 = a2 + kstep; const char* b3 = b2 + kstep;
            if (last && has_next) S.a_ready(nxt);
            PG8_LDB(B0, 0, 0); PG8_SCHED; PG8_LDA(At, 0, 0); PG8_STAGE(PG8_SA(1, 1), a1 + hstep, voffA);
            PG8_WAIT_L(8); PG8_BAR; PG8_WAIT_L(0); PG8_MMA(0, 0, At, B0); PG8_BAR; PG8_SCHED;
            PG8_LDB(B1, 0, 1); PG8_STAGE(PG8_SB(0, 0), b2, voffB);
            PG8_BAR; PG8_WAIT_L(0); PG8_MMA(0, 1, At, B1); PG8_BAR;
            PG8_LDA(At, 0, 1); PG8_STAGE(PG8_SA(0, 0), a2, voffA);
            PG8_BAR; PG8_WAIT_L(0); PG8_MMA(1, 0, At, B0); PG8_BAR; PG8_SCHED;
            PG8_STAGE(PG8_SB(0, 1), b2 + hstep, voffB);
            PG8_WAIT_V(6); PG8_BAR; PG8_MMA(1, 1, At, B1); PG8_BAR;
            PG8_LDB(B0, 1, 0); PG8_SCHED; PG8_LDA(At, 1, 0); PG8_STAGE(PG8_SA(0, 1), a2 + hstep, voffA);
            PG8_WAIT_L(8); PG8_BAR; PG8_WAIT_L(0); PG8_MMA(0, 0, At, B0); PG8_BAR; PG8_SCHED;
            PG8_LDB(B1, 1, 1); PG8_STAGE(PG8_SB(1, 0), b3, voffB);
            PG8_BAR; PG8_WAIT_L(0); PG8_MMA(0, 1, At, B1); PG8_BAR;
            PG8_LDA(At, 1, 1); PG8_STAGE(PG8_SA(1, 0), a3, voffA);
            PG8_BAR; PG8_WAIT_L(0); PG8_MMA(1, 0, At, B0); PG8_BAR; PG8_SCHED;
            PG8_STAGE(PG8_SB(1, 1), b3 + hstep, voffB);
            PG8_WAIT_V(6); PG8_BAR; PG8_MMA(1, 1, At, B1); PG8_BAR;
        }
        PG8_STAMP();
        if constexpr (!Epi::AFTER_DRAIN) { E(acc, cur, wr, wc, fr, fq); S.done(cur); }
        PG8_STAMP();
        if (!has_next) break;
#pragma unroll
        for (int a = 0; a < 2; ++a)
#pragma unroll
            for (int b = 0; b < 2; ++b)
#pragma unroll
                for (int m = 0; m < 4; ++m)
#pragma unroll
                    for (int n = 0; n < 2; ++n) acc[a][b][m][n] = (f32x4){0.f, 0.f, 0.f, 0.f};
        cur = nxt; cA = nA; cB = nB; ++ui;
    }
    PG8_WAIT_V(0);
    if (wr == 0) PG8_BAR;
    PG8_BAR;
    if constexpr (Epi::AFTER_DRAIN) { E.fused(acc, cur, wr, wc, fr, fq, lds, wid, lane); S.done(cur); }
    PG8_STAMP();
    if (STAMP && wid == 0) { stamps[lane] = lane < nts ? (((unsigned long long)(unsigned)ts_hi << 32) | (unsigned)ts_lo) : 0ull;
        if (lane == 62) stamps[62] = rt_entry; if (lane == 63) stamps[63] = (unsigned long long)wall_clock64(); }
#undef PG8_STAMP
#undef PG8_SA
#undef PG8_SB
#undef PG8_STAGE
#undef PG8_LDA
#undef PG8_LDB
#undef PG8_MMA
#undef PG8_WAIT_V
#undef PG8_WAIT_L
#undef PG8_BAR
#undef PG8_SCHED
}
}
using pg8::bf16_t; using pg8::bf16x8; using pg8::f32x4; using pg8::u32x4; using pg8::cvt_pk_bf16;
typedef float f32x2 __attribute__((ext_vector_type(2)));
typedef unsigned u32x2 __attribute__((ext_vector_type(2)));
typedef short s16x4 __attribute__((ext_vector_type(4)));
#define LAS __attribute__((address_space(3)))
typedef LAS unsigned char* LP;
constexpr int T_ = 32768, D_ = 1024, DI_ = 2048, SEQ_ = 2048;
constexpr float EPS_ = 1e-6f;
constexpr size_t MiB = 1024 * 1024;
constexpr size_t WS_WINA = 0, WS_WOUTA = 12 * MiB, WS_WINB = 16 * MiB, WS_WOUTB = 32 * MiB, WS_MOD = 36 * MiB, WS_WSM = 36 * MiB + 512 * 1024,
                 WS_VST = 37 * MiB, WS_H = 46 * MiB, WS_P0 = 110 * MiB, WS_P1 = 238 * MiB, WS_P2 = 366 * MiB, WS_END = 494 * MiB;
constexpr int LDS_BYTES = 131072;
constexpr int NPHASE = 11;

__device__ __forceinline__ float bf2f(unsigned short b) { return __uint_as_float(((unsigned)b) << 16); }
__device__ __forceinline__ float bflo(unsigned w) { return __uint_as_float(w << 16); }
__device__ __forceinline__ float bfhi(unsigned w) { return __uint_as_float(w & 0xffff0000u); }
__device__ __forceinline__ float fexp(float x) { return __builtin_amdgcn_exp2f(x * 1.4426950408889634f); }
__device__ __forceinline__ float sigm(float x) { return __builtin_amdgcn_rcpf(1.0f + fexp(-x)); }
__device__ __forceinline__ float silu_f(float x) { return x * sigm(x); }
__device__ __forceinline__ float gelu_f(float x) { return x * sigm(1.5957691216057308f * (x + 0.044715f * x * x * x)); }
__device__ __forceinline__ float flog(float x) { return __builtin_amdgcn_logf(x) * 0.6931471805599453f; }
__device__ __forceinline__ bf16x8 mk8(s16x4 a, s16x4 b) { return __builtin_shufflevector(a, b, 0, 1, 2, 3, 4, 5, 6, 7); }
__device__ __forceinline__ s16x4 trrd(LP p) { return __builtin_amdgcn_ds_read_tr16_b64_v4i16((LAS s16x4*)p); }
#define MFMA16(a, b, c) __builtin_amdgcn_mfma_f32_16x16x32_bf16((a), (b), (c), 0, 0, 0)

struct EpiA1 {
    static constexpr bool PERM = true, AFTER_DRAIN = false;
    bf16_t* P0; bf16_t* P1; bf16_t* P2; f32x2* vst;
    __device__ __forceinline__ void operator()(const f32x4 (&acc)[2][2][4][2], const pg8::Unit& u, int wr, int wc, int fr, int fq) const {
        const int kind = u.pn >> 3, pt = u.pn & 7;
        bf16_t* base = P0 + (size_t)kind * (size_t)(64 * 1024 * 1024);
        const int row0 = u.pm * 256 + wr * 64 + fr, col0 = pt * 256 + wc * 32 + 8 * fq;
#pragma unroll
        for (int ai = 0; ai < 2; ++ai)
#pragma unroll
            for (int m = 0; m < 4; ++m) {
                const int row = row0 + ai * 128 + m * 16; float s1 = 0.f, s2 = 0.f;
#pragma unroll
                for (int bj = 0; bj < 2; ++bj) {
                    float v[8];
#pragma unroll
                    for (int j = 0; j < 4; ++j) { v[j] = acc[ai][bj][m][0][j]; v[4 + j] = acc[ai][bj][m][1][j]; }
                    if (kind == 2) {
#pragma unroll
                        for (int j = 0; j < 8; ++j) v[j] = silu_f(v[j]);
                    } else {
#pragma unroll
                        for (int j = 0; j < 8; ++j) v[j] = gelu_f(v[j]);
                    }
                    if (kind == 1) {
#pragma unroll
                        for (int j = 0; j < 8; ++j) { s1 += v[j]; s2 += v[j] * v[j]; }
                    }
                    u32x4 w; w.x = cvt_pk_bf16(v[0], v[1]); w.y = cvt_pk_bf16(v[2], v[3]); w.z = cvt_pk_bf16(v[4], v[5]); w.w = cvt_pk_bf16(v[6], v[7]);
                    *(u32x4*)(base + (size_t)row * DI_ + col0 + bj * 128) = w;
                }
                if (kind == 1) {
                    s1 += __shfl_xor(s1, 16); s1 += __shfl_xor(s1, 32); s2 += __shfl_xor(s2, 16); s2 += __shfl_xor(s2, 32);
                    if (fq == 0) vst[(size_t)row * 32 + pt * 4 + wc] = (f32x2){s1, s2};
                }
            }
    }
};
struct EpiRes {
    static constexpr bool PERM = false, AFTER_DRAIN = false;
    const float* xin; float* xout; const float* gate;
    __device__ __forceinline__ void operator()(const f32x4 (&acc)[2][2][4][2], const pg8::Unit& u, int wr, int wc, int fr, int fq) const {
        const int row0 = u.pm * 256 + wr * 64 + fr, col0 = u.pn * 256 + wc * 32 + 4 * fq;
        const int b = (u.pm * 256) >> 11;
        f32x4 gv[2][2];
#pragma unroll
        for (int bj = 0; bj < 2; ++bj)
#pragma unroll
            for (int n = 0; n < 2; ++n) gv[bj][n] = *(const f32x4*)(gate + b * 3072 + col0 + bj * 128 + n * 16);
#pragma unroll
        for (int ai = 0; ai < 2; ++ai)
#pragma unroll
            for (int m = 0; m < 4; ++m) {
                const size_t off = (size_t)(row0 + ai * 128 + m * 16) * D_ + col0;
#pragma unroll
                for (int bj = 0; bj < 2; ++bj)
#pragma unroll
                    for (int n = 0; n < 2; ++n) { const f32x4 xi = *(const f32x4*)(xin + off + bj * 128 + n * 16); *(f32x4*)(xout + off + bj * 128 + n * 16) = xi + gv[bj][n] * acc[ai][bj][m][n]; }
            }
    }
};
struct EpiB1 {
    static constexpr bool PERM = true, AFTER_DRAIN = false;
    bf16_t* P0; bf16_t* P1; bf16_t* P2; const float* lbraw;
    __device__ __forceinline__ void operator()(const f32x4 (&acc)[2][2][4][2], const pg8::Unit& u, int wr, int wc, int fr, int fq) const {
        const int kind = u.pn >> 3, pt = u.pn & 7;
        bf16_t* base = P0 + (size_t)kind * (size_t)(64 * 1024 * 1024);
        const int row0 = u.pm * 256 + wr * 64 + fr, col0 = pt * 256 + wc * 32 + 8 * fq;
        float lb[2][8];
#pragma unroll
        for (int bj = 0; bj < 2; ++bj)
#pragma unroll
            for (int j = 0; j < 8; ++j) lb[bj][j] = 0.f;
        if (kind == 1) {
#pragma unroll
            for (int bj = 0; bj < 2; ++bj)
#pragma unroll
                for (int j = 0; j < 8; ++j) { const int c = col0 + bj * 128 + j; lb[bj][j] = sigm(lbraw[DI_ + c] - lbraw[c]); }
        }
#pragma unroll
        for (int ai = 0; ai < 2; ++ai)
#pragma unroll
            for (int m = 0; m < 4; ++m) {
                const int row = row0 + ai * 128 + m * 16;
#pragma unroll
                for (int bj = 0; bj < 2; ++bj) {
                    float v[8];
#pragma unroll
                    for (int j = 0; j < 4; ++j) { v[j] = acc[ai][bj][m][0][j]; v[4 + j] = acc[ai][bj][m][1][j]; }
                    if (kind == 0) {
#pragma unroll
                        for (int j = 0; j < 8; ++j) v[j] = silu_f(v[j]);
                    } else if (kind == 1) {
#pragma unroll
                        for (int j = 0; j < 8; ++j) v[j] = flog(lb[bj][j] + (1.0f - lb[bj][j]) * sigm(v[j]));
                    }
                    u32x4 w; w.x = cvt_pk_bf16(v[0], v[1]); w.y = cvt_pk_bf16(v[2], v[3]); w.z = cvt_pk_bf16(v[4], v[5]); w.w = cvt_pk_bf16(v[6], v[7]);
                    *(u32x4*)(base + (size_t)row * DI_ + col0 + bj * 128) = w;
                }
            }
    }
};
struct EpiGate {
    static constexpr bool PERM = true, AFTER_DRAIN = false;
    bf16_t* O;
    __device__ __forceinline__ void operator()(const f32x4 (&acc)[2][2][4][2], const pg8::Unit& u, int wr, int wc, int fr, int fq) const {
        const int row0 = u.pm * 256 + wr * 64 + fr, col0 = u.pn * 256 + wc * 32 + 8 * fq;
#pragma unroll
        for (int ai = 0; ai < 2; ++ai)
#pragma unroll
            for (int m = 0; m < 4; ++m) {
                const int row = row0 + ai * 128 + m * 16;
#pragma unroll
                for (int bj = 0; bj < 2; ++bj) {
                    bf16_t* p = O + (size_t)row * DI_ + col0 + bj * 128;
                    const u32x4 o = *(const u32x4*)p;
                    float v[8];
#pragma unroll
                    for (int j = 0; j < 4; ++j) { v[j] = silu_f(acc[ai][bj][m][0][j]); v[4 + j] = silu_f(acc[ai][bj][m][1][j]); }
                    u32x4 w;
                    w.x = cvt_pk_bf16(v[0] * bflo(o.x), v[1] * bfhi(o.x)); w.y = cvt_pk_bf16(v[2] * bflo(o.y), v[3] * bfhi(o.y));
                    w.z = cvt_pk_bf16(v[4] * bflo(o.z), v[5] * bfhi(o.z)); w.w = cvt_pk_bf16(v[6] * bflo(o.w), v[7] * bfhi(o.w));
                    *(u32x4*)p = w;
                }
            }
    }
};

__device__ __forceinline__ void transpose_tile(const float* W, bf16_t* Bt, int K, int N, int k0, int n0, LP L) {
    const int tid = threadIdx.x;
    LAS float* S = (LAS float*)L;
    { const int r = tid >> 3, c = (tid & 7) * 8; const f32x4* src = (const f32x4*)(W + (size_t)(k0 + r) * N + n0 + c); const f32x4 a = src[0], b = src[1];
      LAS float* d = S + r * 65 + c; d[0] = a[0]; d[1] = a[1]; d[2] = a[2]; d[3] = a[3]; d[4] = b[0]; d[5] = b[1]; d[6] = b[2]; d[7] = b[3]; }
    __syncthreads();
    { const int n = tid >> 3, kc = (tid & 7) * 8; float v[8];
#pragma unroll
      for (int j = 0; j < 8; ++j) v[j] = S[(kc + j) * 65 + n];
      u32x4 w; w.x = cvt_pk_bf16(v[0], v[1]); w.y = cvt_pk_bf16(v[2], v[3]); w.z = cvt_pk_bf16(v[4], v[5]); w.w = cvt_pk_bf16(v[6], v[7]);
      *(u32x4*)(Bt + (size_t)(n0 + n) * K + k0 + kc) = w; }
    __syncthreads();
}
__device__ __forceinline__ void mod_unit(const float* c, const float* w_ada, const float* b_ada, float* mod, int unit, LP L) {
    const int tid = threadIdx.x, layer = unit / 96, cgp = unit % 96;
    LAS float* cact = (LAS float*)L;
    LAS float* red = (LAS float*)(L + 65536);
    for (int i = tid; i < 16 * 1024; i += 512) { const int b = i >> 10, k = i & 1023; cact[k * 16 + b] = silu_f(c[i]); }
    __syncthreads();
    const int col = tid & 31, sl = tid >> 5;
    float acc[16];
#pragma unroll
    for (int b = 0; b < 16; ++b) acc[b] = 0.f;
    const float* wp = w_ada + (size_t)layer * 1024 * 3072 + (size_t)(64 * sl) * 3072 + 32 * cgp + col;
#pragma unroll 8
    for (int kk = 0; kk < 64; ++kk) {
        const float w = wp[(size_t)kk * 3072];
        const LAS f32x4* ca = (const LAS f32x4*)(cact + (64 * sl + kk) * 16);
#pragma unroll
        for (int q = 0; q < 4; ++q) { const f32x4 cv = ca[q]; acc[4 * q] += w * cv[0]; acc[4 * q + 1] += w * cv[1]; acc[4 * q + 2] += w * cv[2]; acc[4 * q + 3] += w * cv[3]; }
    }
#pragma unroll
    for (int b = 0; b < 16; ++b) red[(sl * 16 + b) * 32 + col] = acc[b];
    __syncthreads();
    { const int b = tid >> 5; float s = 0.f;
#pragma unroll
      for (int q = 0; q < 16; ++q) s += red[(q * 16 + b) * 32 + col];
      mod[(size_t)(layer * 16 + b) * 3072 + 32 * cgp + col] = s + b_ada[layer * 3072 + 32 * cgp + col]; }
    __syncthreads();
}
struct PrepArgs { const float *c, *w_ada, *b_ada, *a_w_in, *a_w_s, *a_w_out, *b_w_in, *b_w_out; unsigned char* ws; };
__device__ __forceinline__ void prep_phase(const PrepArgs& a, LP L) {
    const int NT = 192 + 32 + 4608;
    for (int t = blockIdx.x; t < NT; t += gridDim.x) {
        if (t < 192) mod_unit(a.c, a.w_ada, a.b_ada, (float*)(a.ws + WS_MOD), t, L);
        else if (t < 224) {
            const int base = (t - 192) * 4096 + threadIdx.x * 8; bf16_t* dst = (bf16_t*)(a.ws + WS_WSM);
            const int tt = (base >> 7) & 127, s0 = base & 127;
            const f32x4 x0 = *(const f32x4*)(a.a_w_s + base), x1 = *(const f32x4*)(a.a_w_s + base + 4);
            const bool z = (tt < 64) && (s0 >= 64);
            u32x4 w; w.x = cvt_pk_bf16(x0[0], x0[1]); w.y = cvt_pk_bf16(x0[2], x0[3]); w.z = cvt_pk_bf16(x1[0], x1[1]); w.w = cvt_pk_bf16(x1[2], x1[3]);
            if (z) w = (u32x4){0u, 0u, 0u, 0u};
            *(u32x4*)(dst + base) = w;
        } else {
            int q = t - 224; const float* W; bf16_t* Bt; int K, N;
            if (q < 1536) { W = a.a_w_in; Bt = (bf16_t*)(a.ws + WS_WINA); K = 1024; N = 6144; }
            else if (q < 2048) { q -= 1536; W = a.a_w_out; Bt = (bf16_t*)(a.ws + WS_WOUTA); K = 2048; N = 1024; }
            else if (q < 4096) { q -= 2048; W = a.b_w_in; Bt = (bf16_t*)(a.ws + WS_WINB); K = 1024; N = 8192; }
            else { q -= 4096; W = a.b_w_out; Bt = (bf16_t*)(a.ws + WS_WOUTB); K = 2048; N = 1024; }
            const int ntn = N / 64; transpose_tile(W, Bt, K, N, (q / ntn) * 64, (q % ntn) * 64, L);
        }
    }
}

__device__ __forceinline__ void hnorm_phase(const float* x, const float* gain, const float* modl, bf16_t* H) {
    const int lane = threadIdx.x & 63, wave = threadIdx.x >> 6;
    for (int row = blockIdx.x * 8 + wave; row < T_; row += gridDim.x * 8) {
        const int b = row >> 11; const f32x4* xr = (const f32x4*)(x + (size_t)row * D_);
        f32x4 v[4]; float ss = 0.f;
#pragma unroll
        for (int i = 0; i < 4; ++i) { v[i] = xr[i * 64 + lane]; ss += v[i][0] * v[i][0] + v[i][1] * v[i][1] + v[i][2] * v[i][2] + v[i][3] * v[i][3]; }
#pragma unroll
        for (int o = 32; o >= 1; o >>= 1) ss += __shfl_xor(ss, o);
        const float rstd = __builtin_amdgcn_rsqf(ss * (1.0f / 1024.0f) + EPS_);
#pragma unroll
        for (int i = 0; i < 4; ++i) {
            const int col = i * 256 + lane * 4;
            const f32x4 g4 = *(const f32x4*)(gain + col), sh = *(const f32x4*)(modl + b * 3072 + col), sc = *(const f32x4*)(modl + b * 3072 + 1024 + col);
            const f32x4 h = v[i] * rstd * g4 * (sc + 1.0f) + sh;
            u32x2 w; w.x = cvt_pk_bf16(h[0], h[1]); w.y = cvt_pk_bf16(h[2], h[3]);
            *(u32x2*)(H + (size_t)row * D_ + col) = w;
        }
    }
}
__device__ __forceinline__ void final_norm_phase(float* xo, const float* gain) {
    const int lane = threadIdx.x & 63, wave = threadIdx.x >> 6;
    for (int row = blockIdx.x * 8 + wave; row < T_; row += gridDim.x * 8) {
        f32x4* xr = (f32x4*)(xo + (size_t)row * D_);
        f32x4 v[4]; float ss = 0.f;
#pragma unroll
        for (int i = 0; i < 4; ++i) { v[i] = xr[i * 64 + lane]; ss += v[i][0] * v[i][0] + v[i][1] * v[i][1] + v[i][2] * v[i][2] + v[i][3] * v[i][3]; }
#pragma unroll
        for (int o = 32; o >= 1; o >>= 1) ss += __shfl_xor(ss, o);
        const float rstd = __builtin_amdgcn_rsqf(ss * (1.0f / 1024.0f) + EPS_);
#pragma unroll
        for (int i = 0; i < 4; ++i) { const f32x4 g4 = *(const f32x4*)(gain + i * 256 + lane * 4); xr[i * 64 + lane] = v[i] * rstd * g4; }
    }
}

constexpr int SP_VN = 0, SP_VN_RS = 544, SP_WS = 128 * 544, SP_WS_RS = 272, SP_ST = SP_WS + 128 * 272;
__device__ __forceinline__ void spatial_phase(LP L, bf16_t* U, const bf16_t* V, const bf16_t* G, const f32x2* vst, const bf16_t* wsm, const float* b_s, const float* ln_gain, const float* ln_bias) {
    const int tid = threadIdx.x, lane = tid & 63, w = tid >> 6, fr = lane & 15, fq = lane >> 4, tq = fr >> 2, tp = fr & 3;
    int cur_g = -1;
    for (int unit = blockIdx.x; unit < 2048; unit += gridDim.x) {
        const int nb = unit >> 3, g = unit & 7;
        __syncthreads();
        if (g != cur_g) {
#pragma unroll
            for (int i = 0; i < 4; ++i) { const int id = tid + 512 * i, r = id >> 4, c = id & 15; *(LAS u32x4*)(L + SP_WS + r * SP_WS_RS + c * 16) = *(const u32x4*)(wsm + (size_t)(g * 128 + r) * 128 + c * 8); }
            cur_g = g;
        }
        if (tid < 128) {
            const f32x2* p = vst + (size_t)(nb * 128 + tid) * 32; float s1 = 0.f, s2 = 0.f;
#pragma unroll
            for (int i = 0; i < 32; ++i) { const f32x2 q = p[i]; s1 += q.x; s2 += q.y; }
            const float mu = s1 * (1.0f / 2048.0f), var = s2 * (1.0f / 2048.0f) - mu * mu;
            *(LAS f32x2*)(L + SP_ST + tid * 8) = (f32x2){mu, __builtin_amdgcn_rsqf(var + EPS_)};
        }
        __syncthreads();
#pragma unroll
        for (int i = 0; i < 8; ++i) {
            const int id = tid + 512 * i, s = id >> 5, c = id & 31;
            const u32x4 raw = *(const u32x4*)(V + (size_t)(nb * 128 + s) * DI_ + g * 256 + c * 8);
            const f32x2 ms = *(const LAS f32x2*)(L + SP_ST + s * 8);
            const f32x4 g0 = *(const f32x4*)(ln_gain + g * 256 + c * 8), g1 = *(const f32x4*)(ln_gain + g * 256 + c * 8 + 4);
            const f32x4 b0 = *(const f32x4*)(ln_bias + g * 256 + c * 8), b1 = *(const f32x4*)(ln_bias + g * 256 + c * 8 + 4);
            float v[8] = {bflo(raw.x), bfhi(raw.x), bflo(raw.y), bfhi(raw.y), bflo(raw.z), bfhi(raw.z), bflo(raw.w), bfhi(raw.w)};
#pragma unroll
            for (int j = 0; j < 4; ++j) { v[j] = (v[j] - ms.x) * ms.y * g0[j] + b0[j]; v[4 + j] = (v[4 + j] - ms.x) * ms.y * g1[j] + b1[j]; }
            u32x4 o; o.x = cvt_pk_bf16(v[0], v[1]); o.y = cvt_pk_bf16(v[2], v[3]); o.z = cvt_pk_bf16(v[4], v[5]); o.w = cvt_pk_bf16(v[6], v[7]);
            *(LAS u32x4*)(L + SP_VN + s * SP_VN_RS + c * 16) = o;
        }
        __syncthreads();
        f32x4 acc[2][8];
#pragma unroll
        for (int dt = 0; dt < 2; ++dt)
#pragma unroll
            for (int tt = 0; tt < 8; ++tt) acc[dt][tt] = (f32x4){0.f, 0.f, 0.f, 0.f};
        bf16x8 af[2][4];
#pragma unroll
        for (int dt = 0; dt < 2; ++dt)
#pragma unroll
            for (int ks = 0; ks < 4; ++ks) {
                LP p = L + SP_VN + (32 * ks + 8 * fq + tq) * SP_VN_RS + (32 * w + 16 * dt) * 2 + 8 * tp;
                af[dt][ks] = mk8(trrd(p), trrd(p + 4 * SP_VN_RS));
            }
#pragma unroll
        for (int tt = 0; tt < 8; ++tt) {
#pragma unroll
            for (int ks = 0; ks < 4; ++ks) {
                if (tt < 4 && ks >= 2) continue;
                const bf16x8 bfr = *(const LAS bf16x8*)(L + SP_WS + (16 * tt + fr) * SP_WS_RS + (32 * ks + 8 * fq) * 2);
                acc[0][tt] = MFMA16(af[0][ks], bfr, acc[0][tt]); acc[1][tt] = MFMA16(af[1][ks], bfr, acc[1][tt]);
            }
        }
#pragma unroll
        for (int tt = 0; tt < 8; ++tt) {
            const int t = 16 * tt + fr; const float bs = b_s[g * 128 + t];
#pragma unroll
            for (int dt = 0; dt < 2; ++dt) {
                const size_t off = (size_t)(nb * 128 + t) * DI_ + g * 256 + 32 * w + 16 * dt + 4 * fq;
                const u32x2 uu = *(const u32x2*)(U + off), gg = *(const u32x2*)(G + off);
                const f32x4 a = acc[dt][tt];
                u32x2 o; o.x = cvt_pk_bf16(bflo(uu.x) * (a[0] + bs) * bflo(gg.x), bfhi(uu.x) * (a[1] + bs) * bfhi(gg.x));
                o.y = cvt_pk_bf16(bflo(uu.y) * (a[2] + bs) * bflo(gg.y), bfhi(uu.y) * (a[3] + bs) * bfhi(gg.y));
                *(u32x2*)(U + off) = o;
            }
        }
    }
}

constexpr int HG_QIN = 0, HG_QIN_RS = 272, HG_KIN = 64 * 272, HG_KIN_RS = 288, HG_IS = HG_KIN + 64 * 288, HG_IS_RS = 288, HG_P = HG_IS + 64 * 288, HG_P_RS = 144,
              HG_ST = HG_P + 64 * 144, HG_ST_RS = 272, HG_TOT = HG_ST + 128 * 272, HG_ER = HG_TOT + 2048, HG_DEC = HG_ER + 512, HG_E2 = HG_DEC + 512, HG_SSQ = HG_E2 + 512, HG_END = HG_SSQ + 512;
static_assert(HG_END <= LDS_BYTES, "hgrn lds");
__device__ __forceinline__ void hgrn_phase(LP L, bf16_t* Q, const bf16_t* LF, const bf16_t* I, const float* gn_gain) {
    const int tid = threadIdx.x, lane = tid & 63, w = tid >> 6, fr = lane & 15, fq = lane >> 4, tq = fr >> 2, tp = fr & 3;
    const int k = tid & 127, seg = tid >> 7;
    for (int unit = blockIdx.x; unit < 256; unit += gridDim.x) {
        const int b = unit >> 4, h = unit & 15;
        const size_t ubase = (size_t)b * SEQ_ * DI_ + h * 128;
        f32x4 st[8];
#pragma unroll
        for (int i = 0; i < 8; ++i) st[i] = (f32x4){0.f, 0.f, 0.f, 0.f};
        unsigned short qv[16], lfv[16]; u32x4 iv[2];
        {
            const size_t cb = ubase + (size_t)(16 * seg) * DI_ + k;
#pragma unroll
            for (int j = 0; j < 16; ++j) { qv[j] = Q[cb + (size_t)j * DI_]; lfv[j] = LF[cb + (size_t)j * DI_]; }
#pragma unroll
            for (int i = 0; i < 2; ++i) { const int id = tid + 512 * i, r = id >> 4, cp = id & 15; iv[i] = *(const u32x4*)(I + ubase + (size_t)r * DI_ + cp * 8); }
        }
        for (int c = 0; c < 32; ++c) {
            const size_t cbase = ubase + (size_t)(64 * c) * DI_;
            float a[16], qf[16], kk[16]; float run = 0.f;
#pragma unroll
            for (int j = 0; j < 16; ++j) { const float lf = bf2f(lfv[j]); run += lf; a[j] = run; kk[j] = 1.0f - fexp(lf); qf[j] = bf2f(qv[j]); }
            *(LAS float*)(L + HG_TOT + (seg * 128 + k) * 4) = run;
#pragma unroll
            for (int i = 0; i < 2; ++i) { const int id = tid + 512 * i, r = id >> 4, cp = id & 15; *(LAS u32x4*)(L + HG_IS + r * HG_IS_RS + cp * 16) = iv[i]; }
            __syncthreads();
            if (c + 1 < 32) {
                const size_t cb = cbase + (size_t)(64 + 16 * seg) * DI_ + k;
#pragma unroll
                for (int j = 0; j < 16; ++j) { qv[j] = Q[cb + (size_t)j * DI_]; lfv[j] = LF[cb + (size_t)j * DI_]; }
#pragma unroll
                for (int i = 0; i < 2; ++i) { const int id = tid + 512 * i, r = id >> 4, cp = id & 15; iv[i] = *(const u32x4*)(I + cbase + (size_t)(64 + r) * DI_ + cp * 8); }
            }
            {
                const float t0 = *(const LAS float*)(L + HG_TOT + k * 4), t1 = *(const LAS float*)(L + HG_TOT + (128 + k) * 4), t2 = *(const LAS float*)(L + HG_TOT + (256 + k) * 4), t3 = *(const LAS float*)(L + HG_TOT + (384 + k) * 4);
                const float aref = t0 + t1, alast = aref + t2 + t3;
                const float pre = (seg > 0 ? t0 : 0.f) + (seg > 1 ? t1 : 0.f) + (seg > 2 ? t2 : 0.f);
#pragma unroll
                for (int j = 0; j < 16; ++j) {
                    const float d = pre + a[j] - aref;
                    const unsigned pk = cvt_pk_bf16(qf[j] * fexp(d), kk[j] * fexp(-d));
                    const int t = 16 * seg + j;
                    *(LAS unsigned short*)(L + HG_QIN + t * HG_QIN_RS + k * 2) = (unsigned short)(pk & 0xffffu);
                    *(LAS unsigned short*)(L + HG_KIN + t * HG_KIN_RS + k * 2) = (unsigned short)(pk >> 16);
                }
                if (seg == 0) { *(LAS float*)(L + HG_ER + k * 4) = fexp(aref); *(LAS float*)(L + HG_DEC + k * 4) = fexp(alast); *(LAS float*)(L + HG_E2 + k * 4) = fexp(alast - aref); }
            }
            __syncthreads();
            {
                const int ti = w >> 1;
                bf16x8 qb[4];
#pragma unroll
                for (int ks = 0; ks < 4; ++ks) qb[ks] = *(const LAS bf16x8*)(L + HG_QIN + (16 * ti + fr) * HG_QIN_RS + (32 * ks + 8 * fq) * 2);
#pragma unroll
                for (int e2 = 0; e2 < 2; ++e2) {
                    const int sj = 2 * (w & 1) + e2;
                    f32x4 sc = (f32x4){0.f, 0.f, 0.f, 0.f};
                    if (sj <= ti) {
#pragma unroll
                        for (int ks = 0; ks < 4; ++ks) { const bf16x8 ka = *(const LAS bf16x8*)(L + HG_KIN + (16 * sj + fr) * HG_KIN_RS + (32 * ks + 8 * fq) * 2); sc = MFMA16(ka, qb[ks], sc); }
                    }
                    const int t = 16 * ti + fr, s0 = 16 * sj + 4 * fq;
                    u32x2 o; o.x = cvt_pk_bf16(s0 <= t ? sc[0] : 0.f, s0 + 1 <= t ? sc[1] : 0.f); o.y = cvt_pk_bf16(s0 + 2 <= t ? sc[2] : 0.f, s0 + 3 <= t ? sc[3] : 0.f);
                    *(LAS u32x2*)(L + HG_P + t * HG_P_RS + s0 * 2) = o;
                }
                const f32x4 er = *(const LAS f32x4*)(L + HG_ER + (16 * w + 4 * fq) * 4);
#pragma unroll
                for (int vt = 0; vt < 8; ++vt) {
                    const f32x4 sv = st[vt] * er; u32x2 o; o.x = cvt_pk_bf16(sv[0], sv[1]); o.y = cvt_pk_bf16(sv[2], sv[3]);
                    *(LAS u32x2*)(L + HG_ST + (16 * vt + fr) * HG_ST_RS + (16 * w + 4 * fq) * 2) = o;
                }
            }
            __syncthreads();
            const int tt = w & 3, vh = w >> 2;
            f32x4 oacc[4];
            {
                bf16x8 pb[2], qb[4];
#pragma unroll
                for (int ks = 0; ks < 2; ++ks) pb[ks] = *(const LAS bf16x8*)(L + HG_P + (16 * tt + fr) * HG_P_RS + (32 * ks + 8 * fq) * 2);
#pragma unroll
                for (int ks = 0; ks < 4; ++ks) qb[ks] = *(const LAS bf16x8*)(L + HG_QIN + (16 * tt + fr) * HG_QIN_RS + (32 * ks + 8 * fq) * 2);
#pragma unroll
                for (int vt = 0; vt < 4; ++vt) {
                    const int V = 4 * vh + vt; f32x4 o = (f32x4){0.f, 0.f, 0.f, 0.f};
#pragma unroll
                    for (int ks = 0; ks < 2; ++ks) {
                        if (ks == 1 && tt < 2) continue;
                        LP p = L + HG_IS + (32 * ks + 8 * fq + tq) * HG_IS_RS + (16 * V) * 2 + 8 * tp;
                        o = MFMA16(mk8(trrd(p), trrd(p + 4 * HG_IS_RS)), pb[ks], o);
                    }
#pragma unroll
                    for (int ks = 0; ks < 4; ++ks) { const bf16x8 sa = *(const LAS bf16x8*)(L + HG_ST + (16 * V + fr) * HG_ST_RS + (32 * ks + 8 * fq) * 2); o = MFMA16(sa, qb[ks], o); }
                    oacc[vt] = o;
                }
                float ss = 0.f;
#pragma unroll
                for (int vt = 0; vt < 4; ++vt) ss += oacc[vt][0] * oacc[vt][0] + oacc[vt][1] * oacc[vt][1] + oacc[vt][2] * oacc[vt][2] + oacc[vt][3] * oacc[vt][3];
                ss += __shfl_xor(ss, 16); ss += __shfl_xor(ss, 32);
                if (fq == 0) *(LAS float*)(L + HG_SSQ + (vh * 64 + 16 * tt + fr) * 4) = ss;
            }
            {
                bf16x8 ka[2];
#pragma unroll
                for (int ks = 0; ks < 2; ++ks) { LP p = L + HG_KIN + (32 * ks + 8 * fq + tq) * HG_KIN_RS + (16 * w) * 2 + 8 * tp; ka[ks] = mk8(trrd(p), trrd(p + 4 * HG_KIN_RS)); }
                const f32x4 dc = *(const LAS f32x4*)(L + HG_DEC + (16 * w + 4 * fq) * 4), e2v = *(const LAS f32x4*)(L + HG_E2 + (16 * w + 4 * fq) * 4);
#pragma unroll
                for (int vt = 0; vt < 8; ++vt) {
                    f32x4 tacc = (f32x4){0.f, 0.f, 0.f, 0.f};
#pragma unroll
                    for (int ks = 0; ks < 2; ++ks) { LP p = L + HG_IS + (32 * ks + 8 * fq + tq) * HG_IS_RS + (16 * vt) * 2 + 8 * tp; tacc = MFMA16(ka[ks], mk8(trrd(p), trrd(p + 4 * HG_IS_RS)), tacc); }
                    st[vt] = dc * st[vt] + e2v * tacc;
                }
            }
            __syncthreads();
            {
                const int t = 16 * tt + fr;
                const float tot = *(const LAS float*)(L + HG_SSQ + t * 4) + *(const LAS float*)(L + HG_SSQ + (64 + t) * 4);
                const float rstd = __builtin_amdgcn_rsqf(tot * (1.0f / 128.0f) + EPS_);
#pragma unroll
                for (int vt = 0; vt < 4; ++vt) {
                    const int v0 = 64 * vh + 16 * vt + 4 * fq; const f32x4 gn = *(const f32x4*)(gn_gain + v0); const f32x4 y = oacc[vt] * rstd * gn;
                    u32x2 o; o.x = cvt_pk_bf16(y[0], y[1]); o.y = cvt_pk_bf16(y[2], y[3]);
                    *(u32x2*)(Q + cbase + (size_t)t * DI_ + v0) = o;
                }
            }
        }
        __syncthreads();
    }
}

struct Params { const float* in[16]; float* out; unsigned char* ws; int ph_lo, ph_hi; };
__global__ void __launch_bounds__(512) mega_fwd(Params p) {
    extern __shared__ __attribute__((aligned(16))) unsigned char lds_raw[];
    LP L = (LP)lds_raw;
    cg::grid_group grid = cg::this_grid();
    unsigned char* ws = p.ws;
    const float* x = p.in[0];
    float* mod = (float*)(ws + WS_MOD);
    bf16_t* H = (bf16_t*)(ws + WS_H); bf16_t* P0 = (bf16_t*)(ws + WS_P0); bf16_t* P1 = (bf16_t*)(ws + WS_P1); bf16_t* P2 = (bf16_t*)(ws + WS_P2);
    const int G = gridDim.x, bx = blockIdx.x;
    const int lo = p.ph_lo, hi = p.ph_hi;
#define IN(k) (PHEN(k) && lo <= (k) && (k) < hi)
#define SEAM(k) do { if (lo <= (k) && (k) + 1 < hi) { __syncthreads(); grid.sync(); } } while (0)
    if (IN(0)) { PrepArgs a{p.in[1], p.in[3], p.in[4], p.in[5], p.in[8], p.in[10], p.in[11], p.in[14], ws}; prep_phase(a, L); }
    SEAM(0);
    if (IN(1)) hnorm_phase(x, p.in[2], mod, H);
    SEAM(1);
    if (IN(2)) { pg8::Gemm g{H, (const bf16_t*)(ws + WS_WINA), T_, 6144, 1024}; pg8::StaticOrder S; S.init(T_, 6144, G, bx); EpiA1 E{P0, P1, P2, (f32x2*)(ws + WS_VST)};
                 pg8::gemm_phase<EpiA1, pg8::StaticOrder>(L, g, S, E, nullptr); }
    SEAM(2);
    if (IN(3)) spatial_phase(L, P0, P1, P2, (const f32x2*)(ws + WS_VST), (const bf16_t*)(ws + WS_WSM), p.in[9], p.in[6], p.in[7]);
    SEAM(3);
    if (IN(4)) { pg8::Gemm g{P0, (const bf16_t*)(ws + WS_WOUTA), T_, 1024, 2048}; pg8::StaticOrder S; S.init(T_, 1024, G, bx); EpiRes E{x, p.out, mod + 2048};
                 pg8::gemm_phase<EpiRes, pg8::StaticOrder>(L, g, S, E, nullptr); }
    SEAM(4);
    if (IN(5)) hnorm_phase(p.out, p.in[2] + 1024, mod + 16 * 3072, H);
    SEAM(5);
    if (IN(6)) { pg8::Gemm g{H, (const bf16_t*)(ws + WS_WINB), T_, 6144, 1024}; pg8::StaticOrder S; S.init(T_, 6144, G, bx); EpiB1 E{P0, P1, P2, p.in[12]};
                 pg8::gemm_phase<EpiB1, pg8::StaticOrder>(L, g, S, E, nullptr); }
    SEAM(6);
    if (IN(7)) hgrn_phase(L, P0, P1, P2, p.in[13]);
    SEAM(7);
    if (IN(8)) { pg8::Gemm g{H, (const bf16_t*)(ws + WS_WINB) + (size_t)6144 * 1024, T_, 2048, 1024}; pg8::StaticOrder S; S.init(T_, 2048, G, bx); EpiGate E{P0};
                 pg8::gemm_phase<EpiGate, pg8::StaticOrder>(L, g, S, E, nullptr); }
    SEAM(8);
    if (IN(9)) { pg8::Gemm g{P0, (const bf16_t*)(ws + WS_WOUTB), T_, 1024, 2048}; pg8::StaticOrder S; S.init(T_, 1024, G, bx); EpiRes E{p.out, p.out, mod + 16 * 3072 + 2048};
                 pg8::gemm_phase<EpiRes, pg8::StaticOrder>(L, g, S, E, nullptr); }
    SEAM(9);
    if (IN(10)) final_norm_phase(p.out, p.in[15]);
#undef IN
#undef SEAM
}

extern "C" void kernel_launch(void* const* d_in, const int* in_sizes, int n_in, void* d_out, int out_size, void* d_ws, size_t ws_size, hipStream_t stream) {
    static int grid_blocks = 0;
    if (!grid_blocks) {
        if (n_in != 16 || ws_size < WS_END) { fprintf(stderr, "kernel_launch: need 16 inputs and >= %zu bytes of workspace; got %d, %zu\n", (size_t)WS_END, n_in, ws_size); grid_blocks = -1; return; }
        int dev = 0, cus = 0, per_cu = 0;
        hipGetDevice(&dev);
        hipDeviceGetAttribute(&cus, hipDeviceAttributeMultiprocessorCount, dev);
        if (hipFuncSetAttribute((const void*)mega_fwd, hipFuncAttributeMaxDynamicSharedMemorySize, LDS_BYTES) != hipSuccess) { fprintf(stderr, "kernel_launch: hipFuncSetAttribute failed\n"); }
        if (hipOccupancyMaxActiveBlocksPerMultiprocessor(&per_cu, (const void*)mega_fwd, 512, LDS_BYTES) != hipSuccess || per_cu < 1) { fprintf(stderr, "kernel_launch: occupancy query failed (%d)\n", per_cu); per_cu = 1; }
        (void)hipGetLastError();
        grid_blocks = cus * per_cu;
        if (grid_blocks > 256) grid_blocks = 256;
    }
    if (grid_blocks < 0) return;
    Params p{};
    for (int i = 0; i < 16; ++i) p.in[i] = (const float*)d_in[i];
    p.out = (float*)d_out; p.ws = (unsigned char*)d_ws;
#if ONE_LAUNCH
    p.ph_lo = 0; p.ph_hi = NPHASE;
    void* args[] = {&p};
    hipError_t e = hipLaunchCooperativeKernel((const void*)mega_fwd, dim3(grid_blocks), dim3(512), args, LDS_BYTES, stream);
    if (e != hipSuccess) fprintf(stderr, "cooperative launch failed: %s (grid %d)\n", hipGetErrorString(e), grid_blocks);
#else
    for (int ph = 0; ph < NPHASE; ++ph) { p.ph_lo = ph; p.ph_hi = ph + 1; hipLaunchKernelGGL(mega_fwd, dim3(grid_blocks), dim3(512), LDS_BYTES, stream, p); }
#endif
}
```

```cpp
#include <hip/hip_runtime.h>
#include <hip/hip_cooperative_groups.h>
#include <cstdio>
namespace cg = cooperative_groups;
namespace pg8 {
#define PG8_LAS __attribute__((address_space(3)))
typedef unsigned short bf16_t;
typedef short bf16x8 __attribute__((ext_vector_type(8)));
typedef float f32x4 __attribute__((ext_vector_type(4)));
typedef unsigned u32x4 __attribute__((ext_vector_type(4)));
constexpr int BM = 256, BK = 64, HALF = 128, HTB = HALF * BK * 2  , STAGE_BYTES = 8 * HTB, NXCD = 8, WGM = 4;

__host__ __device__ __forceinline__ int lds_byte(int r, int c) { const int st = (r >> 4) * 2 + (c >> 5), rr = r & 15, cc = c & 31, ob = rr * 64 + cc * 2; return st * 1024 + (ob ^ (((ob >> 9) & 1) << 5)); }
__host__ __device__ __forceinline__ void stage_rc(int b, int& R, int& C) { const int st = b / 1024, sb = b % 1024, swz = sb ^ (((sb >> 9) & 1) << 5); R = (st >> 1) * 16 + swz / 64; C = (st & 1) * 32 + (swz % 64) / 2; }
__host__ __device__ __forceinline__ int perm32(int rho) { const int n = rho >> 4, i = rho & 15; return 8 * (i >> 2) + 4 * n + (i & 3); }

struct Unit { int pm, pn; };
struct Gemm { const bf16_t* A; const bf16_t* Bt; int M, N, K; };

struct StaticOrder {
    int nM, nN, nwg, G, c;
    __host__ __device__ void init(int M, int N, int G_, int c_) { nM = M / BM; nN = N / BM; nwg = nM * nN; G = G_; c = c_; }
    __host__ __device__ bool next(int i, Unit& u) const {
        const long L = (long)i * G + c; if (L >= nwg) return false;
        int wgid = (int)L; { const int q = nwg / NXCD, r = nwg % NXCD, xcd = wgid % NXCD, off = wgid / NXCD; wgid = (xcd < r ? xcd * (q + 1) : r * (q + 1) + (xcd - r) * q) + off; }
        const int nig = WGM * nN, gid = wgid / nig, fm = gid * WGM, gsz = (nM - fm) < WGM ? (nM - fm) : WGM;
        u.pm = fm + ((wgid % nig) % gsz); u.pn = (wgid % nig) / gsz; return true;
    }
    __device__ __forceinline__ void a_ready(const Unit&) const {}
    __device__ __forceinline__ void done(const Unit&) const {}
};
__device__ __forceinline__ unsigned cvt_pk_bf16(float lo, float hi) { unsigned r; asm volatile("v_cvt_pk_bf16_f32 %0, %1, %2" : "=v"(r) : "v"(lo), "v"(hi)); return r; }
typedef float f32x2 __attribute__((ext_vector_type(2)));
template <class Epi, class Sched, bool STAMP = false>
__device__ __forceinline__ void gemm_phase(PG8_LAS unsigned char* lds, const Gemm g, const Sched& S, const Epi& E, unsigned long long* stamps) {
    const int tid = threadIdx.x, wid = __builtin_amdgcn_readfirstlane(tid >> 6), lane = tid & 63, wr = wid >> 2, wc = wid & 3, fr = lane & 15, fq = lane >> 4;
    const int K = g.K, nt = K / BK;
    int ts_lo = 0, ts_hi = 0, nts = 0; const unsigned long long rt_entry = STAMP ? (unsigned long long)wall_clock64() : 0ull;
#define PG8_STAMP() do { if (STAMP && wid == 0 && nts < 64) { const unsigned long long _c = (unsigned long long)clock64(); \
        ts_lo = (lane == nts) ? (int)(unsigned)_c : ts_lo; ts_hi = (lane == nts) ? (int)(unsigned)(_c >> 32) : ts_hi; ++nts; } } while (0)
    PG8_STAMP();
    unsigned voffA[2], voffB[2];
#pragma unroll
    for (int i = 0; i < 2; ++i) { int R, C; stage_rc(tid * 16 + i * 8192, R, C); const int Rb = Epi::PERM ? ((R & ~31) + perm32(R & 31)) : R;
        voffA[i] = (unsigned)(R * K + C) * 2u; voffB[i] = (unsigned)(Rb * K + C) * 2u; }
    const size_t kstep = (size_t)(BK * 2);
    const size_t hstep = (size_t)HALF * K * 2;
    const size_t tstep = 2 * hstep;
    const unsigned ldsw = (unsigned)wid * 1024u;
    const int aoff = lds_byte(wr * 64 + fr, fq * 8), boff = lds_byte(wc * 32 + fr, fq * 8);
#define PG8_SA(b, h) (((b) * 2 + (h)) * HTB)
#define PG8_SB(b, h) ((4 + (b) * 2 + (h)) * HTB)
#define PG8_STAGE(bufoff, gbase, voff) do { _Pragma("unroll") for (int _i = 0; _i < 2; ++_i) \
        __builtin_amdgcn_global_load_lds((const unsigned*)((const char*)(gbase) + (voff)[_i]), (PG8_LAS unsigned*)(lds + (bufoff) + ldsw + _i * 8192), 16, 0, 0); } while (0)
#define PG8_LDA(dst, b, h) do { _Pragma("unroll") for (int m = 0; m < 4; ++m) _Pragma("unroll") for (int k = 0; k < 2; ++k) dst[m][k] = *(const PG8_LAS bf16x8*)(lds + PG8_SA(b, h) + aoff + m * 2048 + k * 1024); } while (0)
#define PG8_LDB(dst, b, h) do { _Pragma("unroll") for (int n = 0; n < 2; ++n) _Pragma("unroll") for (int k = 0; k < 2; ++k) dst[n][k] = *(const PG8_LAS bf16x8*)(lds + PG8_SB(b, h) + boff + n * 2048 + k * 1024); } while (0)
#define PG8_MMA(ai, bj, At, Bt) do { __builtin_amdgcn_s_setprio(1); _Pragma("unroll") for (int m = 0; m < 4; ++m) _Pragma("unroll") for (int n = 0; n < 2; ++n) _Pragma("unroll") for (int k = 0; k < 2; ++k) \
        acc[ai][bj][m][n] = __builtin_amdgcn_mfma_f32_16x16x32_bf16(Bt[n][k], At[m][k], acc[ai][bj][m][n], 0, 0, 0); __builtin_amdgcn_s_setprio(0); } while (0)
#define PG8_WAIT_V(n) asm volatile("s_waitcnt vmcnt(" #n ")" ::: "memory")
#define PG8_WAIT_L(n) asm volatile("s_waitcnt lgkmcnt(" #n ")" ::: "memory")
#define PG8_BAR __builtin_amdgcn_s_barrier()
#define PG8_SCHED __builtin_amdgcn_sched_barrier(0)
    Unit cur, nxt; int ui = 0;
    if (!S.next(0, cur)) return;
    f32x4 acc[2][2][4][2];
#pragma unroll
    for (int a = 0; a < 2; ++a)
#pragma unroll
        for (int b = 0; b < 2; ++b)
#pragma unroll
            for (int m = 0; m < 4; ++m)
#pragma unroll
                for (int n = 0; n < 2; ++n) acc[a][b][m][n] = (f32x4){0.f, 0.f, 0.f, 0.f};
    bf16x8 At[4][2], B0[2][2], B1[2][2];
    const char* cA = (const char*)g.A + (size_t)cur.pm * tstep; const char* cB = (const char*)g.Bt + (size_t)cur.pn * tstep;
    S.a_ready(cur);
    PG8_STAGE(PG8_SB(0, 0), cB, voffB); PG8_STAGE(PG8_SA(0, 0), cA, voffA); PG8_STAGE(PG8_SB(0, 1), cB + hstep, voffB); PG8_STAGE(PG8_SA(0, 1), cA + hstep, voffA);
    if (wr == 1) PG8_BAR;
    PG8_WAIT_V(4); PG8_BAR;
    PG8_STAGE(PG8_SB(1, 0), cB + kstep, voffB); PG8_STAGE(PG8_SA(1, 0), cA + kstep, voffA); PG8_STAGE(PG8_SB(1, 1), cB + hstep + kstep, voffB);
    PG8_WAIT_V(6); PG8_BAR;
    PG8_STAMP();
    for (;;) {
        const bool has_next = S.next(ui + 1, nxt);
        const char* nA = has_next ? (const char*)g.A + (size_t)nxt.pm * tstep : cA; const char* nB = has_next ? (const char*)g.Bt + (size_t)nxt.pn * tstep : cB;
        for (int t = 0; t < nt; t += 2) {
            const bool last = (t == nt - 2);
            const char* a1 = cA + (size_t)(t + 1) * kstep;
            const char* a2 = last ? nA : cA + (size_t)(t + 2) * kstep; const char* b2 = last ? nB : cB + (size_t)(t + 2) * kstep;
            const char* a3 = a2 + kstep; const char* b3 = b2 + kstep;
            if (last && has_next) S.a_ready(nxt);
            PG8_LDB(B0, 0, 0); PG8_SCHED; PG8_LDA(At, 0, 0); PG8_STAGE(PG8_SA(1, 1), a1 + hstep, voffA);
            PG8_WAIT_L(8); PG8_BAR; PG8_WAIT_L(0); PG8_MMA(0, 0, At, B0); PG8_BAR; PG8_SCHED;
            PG8_LDB(B1, 0, 1); PG8_STAGE(PG8_SB(0, 0), b2, voffB);
            PG8_BAR; PG8_WAIT_L(0); PG8_MMA(0, 1, At, B1); PG8_BAR;
            PG8_LDA(At, 0, 1); PG8_STAGE(PG8_SA(0, 0), a2, voffA);
            PG8_BAR; PG8_WAIT_L(0); PG8_MMA(1, 0, At, B0); PG8_BAR; PG8_SCHED;
            PG8_STAGE(PG8_SB(0, 1), b2 + hstep, voffB);
            PG8_WAIT_V(6); PG8_BAR; PG8_MMA(1, 1, At, B1); PG8_BAR;
            PG8_LDB(B0, 1, 0); PG8_SCHED; PG8_LDA(At, 1, 0); PG8_STAGE(PG8_SA(0, 1), a2 + hstep, voffA);
            PG8_WAIT_L(8); PG8_BAR; PG8_WAIT_L(0); PG8_MMA(0, 0, At, B0); PG8_BAR; PG8_SCHED;
            PG8_LDB(B1, 1, 1); PG8_STAGE(PG8_SB(1, 0), b3, voffB);
            PG8_BAR; PG8_WAIT_L(0); PG8_MMA(0, 1, At, B1); PG8_BAR;
            PG8_LDA(At, 1, 1); PG8_STAGE(PG8_SA(1, 0), a3, voffA);
            PG8_BAR; PG8_WAIT_L(0); PG8_MMA(1, 0, At, B0); PG8_BAR; PG8_SCHED;
            PG8_STAGE(PG8_SB(1, 1), b3 + hstep, voffB);
            PG8_WAIT_V(6); PG8_BAR; PG8_MMA(1, 1, At, B1); PG8_BAR;
        }
        PG8_STAMP();
        if constexpr (!Epi::AFTER_DRAIN) { E(acc, cur, wr, wc, fr, fq); S.done(cur); }
        PG8_STAMP();
        if (!has_next) break;
#pragma unroll
        for (int a = 0; a < 2; ++a)
#pragma unroll
            for (int b = 0; b < 2; ++b)
#pragma unroll
                for (int m = 0; m < 4; ++m)
#pragma unroll
                    for (int n = 0; n < 2; ++n) acc[a][b][m][n] = (f32x4){0.f, 0.f, 0.f, 0.f};
        cur = nxt; cA = nA; cB = nB; ++ui;
    }
    PG8_WAIT_V(0);
    if (wr == 0) PG8_BAR;
    PG8_BAR;
    if constexpr (Epi::AFTER_DRAIN) { E.fused(acc, cur, wr, wc, fr, fq, lds, wid, lane); S.done(cur); }
    PG8_STAMP();
    if (STAMP && wid == 0) { stamps[lane] = lane < nts ? (((unsigned long long)(unsigned)ts_hi << 32) | (unsigned)ts_lo) : 0ull;
        if (lane == 62) stamps[62] = rt_entry; if (lane == 63) stamps[63] = (unsigned long long)wall_clock64(); }
#undef PG8_STAMP
#undef PG8_SA
#undef PG8_SB
#undef PG8_STAGE
#undef PG8_LDA
#undef PG8_LDB
#undef PG8_MMA
#undef PG8_WAIT_V
#undef PG8_WAIT_L
#undef PG8_BAR
#undef PG8_SCHED
}
}
using pg8::bf16_t; using pg8::bf16x8; using pg8::f32x4; using pg8::u32x4;
typedef float f32x2 __attribute__((ext_vector_type(2)));
typedef __bf16 bf16x2_t __attribute__((ext_vector_type(2)));
__device__ __forceinline__ unsigned cvt_pk_bf16(float lo, float hi) { const bf16x2_t r = __builtin_convertvector((f32x2){lo, hi}, bf16x2_t); return __builtin_bit_cast(unsigned, r); }
typedef unsigned u32x2 __attribute__((ext_vector_type(2)));
typedef short s16x4 __attribute__((ext_vector_type(4)));
#define LAS __attribute__((address_space(3)))
typedef LAS unsigned char* LP;
#define XB_TMO      128
#define XB_XCNT(j)  (256  + 64 * (j))
#define XB_XSUB(j)  (1280 + 64 * (j))
#define XB_XGEN(j)  (2304 + 64 * (j))
#define XB_TOP      3328
#define XB_TOPGEN   3392
#define XCD_BAR_WORDS 3456
#define XB_SPIN_CAP (1u << 18)

__device__ __forceinline__ unsigned xb_ld(unsigned* p)              { return __hip_atomic_load(p, __ATOMIC_RELAXED, __HIP_MEMORY_SCOPE_AGENT); }
__device__ __forceinline__ unsigned xb_add(unsigned* p, unsigned v) { return __hip_atomic_fetch_add(p, v, __ATOMIC_RELAXED, __HIP_MEMORY_SCOPE_AGENT); }
__device__ __forceinline__ unsigned xb_xcc_id() { return (unsigned)__builtin_amdgcn_s_getreg((3 << 11) | 20) & 0xFu; }
#define XB_SPIN(cond, bar) do { unsigned _sp = 0; while (cond) { __builtin_amdgcn_s_sleep(1); \
    if ((++_sp & 255u) == 0u) { if (xb_ld(&(bar)[XB_TMO])) break; if (_sp > XB_SPIN_CAP) { atomicAdd(&(bar)[XB_TMO], 1u); break; } } } } while (0)

struct XcdBarrier {
    unsigned* bar; unsigned x;
    volatile LAS unsigned* st;
};

__device__ __forceinline__ XcdBarrier xcd_barrier_post(unsigned* bar, volatile LAS unsigned* st) {
    XcdBarrier b; b.bar = bar; b.x = xb_xcc_id(); b.st = st;
    if (threadIdx.x == 0) (void)xb_add(&bar[XB_XCNT(b.x)], 1u);
    return b;
}
__device__ __forceinline__ void xcd_barrier_complete(unsigned* bar, unsigned x, unsigned& nloc, unsigned& nx) {
    const unsigned G = gridDim.x * gridDim.y * gridDim.z;
    unsigned sum, cnt, mine, sp = 0u;
    for (;;) {
        sum = 0u; cnt = 0u; mine = 0u;
#pragma unroll
        for (unsigned j = 0; j < 16; ++j) { const unsigned c = xb_ld(&bar[XB_XCNT(j)]); sum += c; cnt += (c > 0u) ? 1u : 0u; mine = (j == x) ? c : mine; }
        if (sum == G) break;
        __builtin_amdgcn_s_sleep(1);
        if ((++sp & 255u) == 0u) { if (xb_ld(&bar[XB_TMO])) break; if (sp > XB_SPIN_CAP) { atomicAdd(&bar[XB_TMO], 1u); break; } }
    }
    nloc = mine > 0u ? mine : 1u; nx = cnt > 0u ? cnt : 1u;
}

__device__ __forceinline__ void xcd_barrier(const XcdBarrier& b) {
    asm volatile("s_waitcnt vmcnt(0)" ::: "memory");
    __syncthreads();
    if (threadIdx.x == 0) {
        unsigned* bar = b.bar;
        __builtin_amdgcn_s_waitcnt(0);
        unsigned nloc = b.st[0], nx = b.st[1];
        if (nloc == 0u) { xcd_barrier_complete(bar, b.x, nloc, nx); b.st[0] = nloc; b.st[1] = nx; }
        const unsigned old = xb_add(&bar[XB_XSUB(b.x)], 1u);
        const unsigned gen = old / nloc;
        if (old + 1u == (gen + 1u) * nloc) {
            __builtin_amdgcn_fence(__ATOMIC_RELEASE, "agent");
            asm volatile("s_waitcnt vmcnt(0)" ::: "memory");
            const unsigned og = xb_add(&bar[XB_TOP], 1u);
            const unsigned tg = og / nx;
            if (og + 1u == (tg + 1u) * nx) xb_add(&bar[XB_TOPGEN], 1u);
            else XB_SPIN(xb_ld(&bar[XB_TOPGEN]) == tg, bar);
            __builtin_amdgcn_fence(__ATOMIC_ACQUIRE, "agent");
            xb_add(&bar[XB_XGEN(b.x)], 1u);
            asm volatile("s_waitcnt vmcnt(0)" ::: "memory");
        } else {
            XB_SPIN(xb_ld(&bar[XB_XGEN(b.x)]) == gen, bar);
            __builtin_amdgcn_fence(__ATOMIC_ACQUIRE, "agent");
            asm volatile("s_waitcnt vmcnt(0)" ::: "memory");
        }
    }
    __syncthreads();
}

constexpr int T_ = 32768, D_ = 1024, DI_ = 2048, SEQ_ = 2048;
constexpr float EPS_ = 1e-6f;
constexpr size_t MiB = 1024 * 1024;
constexpr size_t WS_WINA = 0, WS_WOUTA = 12 * MiB, WS_WINB = 16 * MiB, WS_WOUTB = 32 * MiB, WS_MOD = 36 * MiB, WS_WSM = 36 * MiB + 512 * 1024,
                 WS_VST = 37 * MiB, WS_H = 46 * MiB, WS_P0 = 110 * MiB, WS_P1 = 238 * MiB, WS_P2 = 366 * MiB, WS_END = 494 * MiB;
constexpr int LDS_BAR_OFF = 155648;
constexpr int LDS_BYTES = LDS_BAR_OFF + 16;
constexpr size_t WS_BAR = 45 * MiB;
constexpr int NPHASE = 11;

__device__ __forceinline__ float bf2f(unsigned short b) { return __uint_as_float(((unsigned)b) << 16); }
__device__ __forceinline__ float bflo(unsigned w) { return __uint_as_float(w << 16); }
__device__ __forceinline__ float bfhi(unsigned w) { return __uint_as_float(w & 0xffff0000u); }
__device__ __forceinline__ float fexp(float x) { return __builtin_amdgcn_exp2f(x * 1.4426950408889634f); }
__device__ __forceinline__ float sigm(float x) { return __builtin_amdgcn_rcpf(1.0f + fexp(-x)); }
__device__ __forceinline__ float silu_f(float x) { return x * sigm(x); }
__device__ __forceinline__ float gelu_f(float x) { return x * sigm(1.5957691216057308f * (x + 0.044715f * x * x * x)); }
__device__ __forceinline__ float flog(float x) { return __builtin_amdgcn_logf(x) * 0.6931471805599453f; }
__device__ __forceinline__ bf16x8 mk8(s16x4 a, s16x4 b) { return __builtin_shufflevector(a, b, 0, 1, 2, 3, 4, 5, 6, 7); }
__device__ __forceinline__ s16x4 trrd(LP p) { return __builtin_amdgcn_ds_read_tr16_b64_v4i16((LAS s16x4*)p); }
__device__ __forceinline__ f32x2 ex2_2(f32x2 q) { f32x2 e; e.x = __builtin_amdgcn_exp2f(q.x); e.y = __builtin_amdgcn_exp2f(q.y); return e; }
__device__ __forceinline__ f32x2 rcp_2(f32x2 d) { f32x2 r; r.x = __builtin_amdgcn_rcpf(d.x); r.y = __builtin_amdgcn_rcpf(d.y); return r; }
__device__ __forceinline__ f32x2 sigm2(f32x2 x) { return rcp_2(ex2_2(x * -1.4426950408889634f) + 1.0f); }
__device__ __forceinline__ f32x2 silu2(f32x2 x) { return x * sigm2(x); }
__device__ __forceinline__ f32x2 gelu2(f32x2 x) { const f32x2 t = x * x; const f32x2 p = t * -0.10294323974f + -2.3022081983f; return x * rcp_2(ex2_2(p * x) + 1.0f); }
__device__ __forceinline__ void lds_barrier() { asm volatile("s_waitcnt lgkmcnt(0)" ::: "memory"); __builtin_amdgcn_s_barrier(); asm volatile("" ::: "memory"); }
__device__ __forceinline__ f32x2 gelu_silu2(f32x2 u, f32x2 g) { const f32x2 t = u * u; const f32x2 p = t * -0.10294323974f + -2.3022081983f; const f32x2 eu = ex2_2(p * u) + 1.0f, eg = ex2_2(g * -1.4426950408889634f) + 1.0f; return (u * g) * rcp_2(eu * eg); }
#define MFMA16(a, b, c) __builtin_amdgcn_mfma_f32_16x16x32_bf16((a), (b), (c), 0, 0, 0)

struct EpiV {
    static constexpr bool PERM = true, AFTER_DRAIN = false;
    bf16_t* Vo; f32x2* vst;
    __device__ __forceinline__ void operator()(const f32x4 (&acc)[2][2][4][2], const pg8::Unit& u, int wr, int wc, int fr, int fq) const {
        const int row0 = u.pm * 256 + wr * 64 + fr, col0 = u.pn * 256 + wc * 32 + 8 * fq;
#pragma unroll
        for (int ai = 0; ai < 2; ++ai)
#pragma unroll
            for (int m = 0; m < 4; ++m) {
                const int row = row0 + ai * 128 + m * 16; float s1 = 0.f, s2 = 0.f;
#pragma unroll
                for (int bj = 0; bj < 2; ++bj) {
                    float v[8];
#pragma unroll
                    for (int j = 0; j < 4; j += 2) { const f32x2 r0 = gelu2((f32x2){acc[ai][bj][m][0][j], acc[ai][bj][m][0][j + 1]}), r1 = gelu2((f32x2){acc[ai][bj][m][1][j], acc[ai][bj][m][1][j + 1]});
                        v[j] = r0.x; v[j + 1] = r0.y; v[4 + j] = r1.x; v[4 + j + 1] = r1.y; }
#pragma unroll
                    for (int j = 0; j < 8; ++j) { s1 += v[j]; s2 += v[j] * v[j]; }
                    u32x4 w; w.x = cvt_pk_bf16(v[0], v[1]); w.y = cvt_pk_bf16(v[2], v[3]); w.z = cvt_pk_bf16(v[4], v[5]); w.w = cvt_pk_bf16(v[6], v[7]);
                    *(u32x4*)(Vo + (size_t)row * DI_ + col0 + bj * 128) = w;
                }
                s1 += __shfl_xor(s1, 16); s1 += __shfl_xor(s1, 32); s2 += __shfl_xor(s2, 16); s2 += __shfl_xor(s2, 32);
                if (fq == 0) vst[(size_t)(u.pn * 4 + wc) * T_ + row] = (f32x2){s1, s2};
            }
    }
};
struct EpiUG {
    static constexpr bool PERM = true, AFTER_DRAIN = false;
    const bf16_t* S; bf16_t* Y;
    __device__ __forceinline__ void operator()(const f32x4 (&acc)[2][2][4][2], const pg8::Unit& u, int wr, int wc, int fr, int fq) const {
        const int row0 = u.pm * 256 + wr * 64 + fr, col0 = u.pn * 128 + wc * 32 + 8 * fq;
        u32x4 svv[2][4];
#pragma unroll
        for (int ai = 0; ai < 2; ++ai)
#pragma unroll
            for (int m = 0; m < 4; ++m) svv[ai][m] = *(const u32x4*)(S + (size_t)(row0 + ai * 128 + m * 16) * DI_ + col0);
#pragma unroll
        for (int ai = 0; ai < 2; ++ai)
#pragma unroll
            for (int m = 0; m < 4; ++m) {
                const size_t off = (size_t)(row0 + ai * 128 + m * 16) * DI_ + col0;
                const u32x4 sv = svv[ai][m];
                float v[8];
#pragma unroll
                for (int n = 0; n < 2; ++n)
#pragma unroll
                    for (int j = 0; j < 4; j += 2) { const f32x2 r = gelu_silu2((f32x2){acc[ai][0][m][n][j], acc[ai][0][m][n][j + 1]}, (f32x2){acc[ai][1][m][n][j], acc[ai][1][m][n][j + 1]}); v[4 * n + j] = r.x; v[4 * n + j + 1] = r.y; }
                u32x4 w;
                w.x = cvt_pk_bf16(v[0] * bflo(sv.x), v[1] * bfhi(sv.x)); w.y = cvt_pk_bf16(v[2] * bflo(sv.y), v[3] * bfhi(sv.y));
                w.z = cvt_pk_bf16(v[4] * bflo(sv.z), v[5] * bfhi(sv.z)); w.w = cvt_pk_bf16(v[6] * bflo(sv.w), v[7] * bfhi(sv.w));
                *(u32x4*)(Y + off) = w;
            }
    }
};
template <bool ADD> struct EpiDelta {
    static constexpr bool PERM = true, AFTER_DRAIN = false;
    const bf16_t* Din; bf16_t* Dout; const float* gate;
    __device__ __forceinline__ void operator()(const f32x4 (&acc)[2][2][4][2], const pg8::Unit& u, int wr, int wc, int fr, int fq) const {
        const int row0 = u.pm * 256 + wr * 64 + fr, col0 = u.pn * 256 + wc * 32 + 8 * fq;
        const int b = (u.pm * 256) >> 11;
        f32x4 gv[2][2];
#pragma unroll
        for (int bj = 0; bj < 2; ++bj)
#pragma unroll
            for (int n = 0; n < 2; ++n) gv[bj][n] = *(const f32x4*)(gate + b * 3072 + col0 + bj * 128 + n * 4);
        u32x4 dv[2][4][2];
        if (ADD) {
#pragma unroll
            for (int ai = 0; ai < 2; ++ai)
#pragma unroll
                for (int m = 0; m < 4; ++m)
#pragma unroll
                    for (int bj = 0; bj < 2; ++bj) dv[ai][m][bj] = *(const u32x4*)(Din + (size_t)(row0 + ai * 128 + m * 16) * D_ + col0 + bj * 128);
        }
#pragma unroll
        for (int ai = 0; ai < 2; ++ai)
#pragma unroll
            for (int m = 0; m < 4; ++m) {
                const size_t off = (size_t)(row0 + ai * 128 + m * 16) * D_ + col0;
#pragma unroll
                for (int bj = 0; bj < 2; ++bj) {
                    f32x4 v0 = gv[bj][0] * acc[ai][bj][m][0], v1 = gv[bj][1] * acc[ai][bj][m][1];
                    if (ADD) { const u32x4 o = dv[ai][m][bj];
                        v0[0] += bflo(o.x); v0[1] += bfhi(o.x); v0[2] += bflo(o.y); v0[3] += bfhi(o.y); v1[0] += bflo(o.z); v1[1] += bfhi(o.z); v1[2] += bflo(o.w); v1[3] += bfhi(o.w); }
                    u32x4 w; w.x = cvt_pk_bf16(v0[0], v0[1]); w.y = cvt_pk_bf16(v0[2], v0[3]); w.z = cvt_pk_bf16(v1[0], v1[1]); w.w = cvt_pk_bf16(v1[2], v1[3]);
                    *(u32x4*)(Dout + off + bj * 128) = w;
                }
            }
    }
};
struct EpiB1 {
    static constexpr bool PERM = true, AFTER_DRAIN = false;
    bf16_t* P0; bf16_t* P1; bf16_t* P2; const float* lbraw;
    template <int KIND> __device__ __forceinline__ void body(const f32x4 (&acc)[2][2][4][2], bf16_t* base, int row0, int col0) const {
        float lb[2][8];
        if (KIND == 1) {
#pragma unroll
            for (int bj = 0; bj < 2; ++bj) {
                const f32x4 a0 = *(const f32x4*)(lbraw + col0 + bj * 128), a1 = *(const f32x4*)(lbraw + col0 + bj * 128 + 4), c0 = *(const f32x4*)(lbraw + DI_ + col0 + bj * 128), c1 = *(const f32x4*)(lbraw + DI_ + col0 + bj * 128 + 4);
#pragma unroll
                for (int j = 0; j < 4; ++j) { lb[bj][j] = sigm(c0[j] - a0[j]); lb[bj][4 + j] = sigm(c1[j] - a1[j]); }
            }
        }
#pragma unroll
        for (int ai = 0; ai < 2; ++ai)
#pragma unroll
            for (int m = 0; m < 4; ++m) {
                const int row = row0 + ai * 128 + m * 16;
#pragma unroll
                for (int bj = 0; bj < 2; ++bj) {
                    float v[8];
#pragma unroll
                    for (int j = 0; j < 4; ++j) { v[j] = acc[ai][bj][m][0][j]; v[4 + j] = acc[ai][bj][m][1][j]; }
                    if (KIND == 0) {
#pragma unroll
                        for (int j = 0; j < 8; j += 2) { const f32x2 r = silu2((f32x2){v[j], v[j + 1]}); v[j] = r.x; v[j + 1] = r.y; }
                    } else if (KIND == 1) {
#pragma unroll
                        for (int j = 0; j < 8; j += 2) { const f32x2 sg = sigm2((f32x2){v[j], v[j + 1]}), l2 = (f32x2){lb[bj][j], lb[bj][j + 1]}; const f32x2 f = (sg - l2 * sg) + l2;
                            v[j] = __builtin_amdgcn_logf(f.x); v[j + 1] = __builtin_amdgcn_logf(f.y); }
                    }
                    u32x4 w; w.x = cvt_pk_bf16(v[0], v[1]); w.y = cvt_pk_bf16(v[2], v[3]); w.z = cvt_pk_bf16(v[4], v[5]); w.w = cvt_pk_bf16(v[6], v[7]);
                    __builtin_nontemporal_store(w, (u32x4*)(base + (size_t)row * DI_ + col0 + bj * 128));
                }
            }
    }
    __device__ __forceinline__ void operator()(const f32x4 (&acc)[2][2][4][2], const pg8::Unit& u, int wr, int wc, int fr, int fq) const {
        const int kind = u.pn >> 3, pt = u.pn & 7;
        bf16_t* base = P0 + (size_t)kind * (size_t)(64 * 1024 * 1024);
        const int row0 = u.pm * 256 + wr * 64 + fr, col0 = pt * 256 + wc * 32 + 8 * fq;
        if (kind == 0) body<0>(acc, base, row0, col0); else if (kind == 1) body<1>(acc, base, row0, col0); else body<2>(acc, base, row0, col0);
    }
};
struct EpiGate {
    static constexpr bool PERM = true, AFTER_DRAIN = false;
    bf16_t* O;
    __device__ __forceinline__ void operator()(const f32x4 (&acc)[2][2][4][2], const pg8::Unit& u, int wr, int wc, int fr, int fq) const {
        const int row0 = u.pm * 256 + wr * 64 + fr, col0 = u.pn * 256 + wc * 32 + 8 * fq;
        u32x4 ov[2][4][2];
#pragma unroll
        for (int ai = 0; ai < 2; ++ai)
#pragma unroll
            for (int m = 0; m < 4; ++m)
#pragma unroll
                for (int bj = 0; bj < 2; ++bj) ov[ai][m][bj] = *(const u32x4*)(O + (size_t)(row0 + ai * 128 + m * 16) * DI_ + col0 + bj * 128);
#pragma unroll
        for (int ai = 0; ai < 2; ++ai)
#pragma unroll
            for (int m = 0; m < 4; ++m) {
                const int row = row0 + ai * 128 + m * 16;
#pragma unroll
                for (int bj = 0; bj < 2; ++bj) {
                    bf16_t* p = O + (size_t)row * DI_ + col0 + bj * 128;
                    const u32x4 o = ov[ai][m][bj];
                    float v[8];
#pragma unroll
                    for (int j = 0; j < 4; j += 2) { const f32x2 r0 = silu2((f32x2){acc[ai][bj][m][0][j], acc[ai][bj][m][0][j + 1]}), r1 = silu2((f32x2){acc[ai][bj][m][1][j], acc[ai][bj][m][1][j + 1]});
                        v[j] = r0.x; v[j + 1] = r0.y; v[4 + j] = r1.x; v[4 + j + 1] = r1.y; }
                    u32x4 w;
                    w.x = cvt_pk_bf16(v[0] * bflo(o.x), v[1] * bfhi(o.x)); w.y = cvt_pk_bf16(v[2] * bflo(o.y), v[3] * bfhi(o.y));
                    w.z = cvt_pk_bf16(v[4] * bflo(o.z), v[5] * bfhi(o.z)); w.w = cvt_pk_bf16(v[6] * bflo(o.w), v[7] * bfhi(o.w));
                    *(u32x4*)p = w;
                }
            }
    }
};

__device__ __forceinline__ void transpose_tile(const float* W, bf16_t* Bt, int K, int N, int k0, int n0, LP L, int dmode) {
    const int tid = threadIdx.x;
    LAS float* S = (LAS float*)L;
    f32x4 ld[8];
#pragma unroll
    for (int i = 0; i < 8; ++i) ld[i] = __builtin_nontemporal_load((const f32x4*)(W + (size_t)(k0 + i * 8 + (tid >> 6)) * N + n0 + (tid & 63) * 4));
#pragma unroll
    for (int i = 0; i < 8; ++i) *(LAS f32x4*)(S + (i * 8 + (tid >> 6)) * 260 + (tid & 63) * 4) = ld[i];
    __syncthreads();
    { const int n = tid & 255, kh = (tid >> 8) * 32;
      int drow = n0 + n;
      if (dmode == 1) { const int kind = n0 >> 11, c0 = n0 & 2047; drow = (kind == 1) ? (c0 + n) : (2048 + 256 * ((c0 >> 7) + (n >> 7)) + (kind == 2 ? 128 : 0) + (n & 127)); }
#pragma unroll
      for (int q = 0; q < 4; ++q) {
          float v[8];
#pragma unroll
          for (int j = 0; j < 8; ++j) v[j] = S[(kh + q * 8 + j) * 260 + n];
          u32x4 w; w.x = cvt_pk_bf16(v[0], v[1]); w.y = cvt_pk_bf16(v[2], v[3]); w.z = cvt_pk_bf16(v[4], v[5]); w.w = cvt_pk_bf16(v[6], v[7]);
          *(u32x4*)(Bt + (size_t)drow * K + k0 + kh + q * 8) = w;
      } }
    __syncthreads();
}
__device__ __forceinline__ void mod_unit(const float* c, const float* w_ada, const float* b_ada, float* mod, int unit, LP L) {
    const int tid = threadIdx.x, layer = unit / 96, cgp = unit % 96;
    LAS float* cact = (LAS float*)L;
    LAS float* red = (LAS float*)(L + 65536);
    for (int i = tid; i < 16 * 1024; i += 512) { const int b = i >> 10, k = i & 1023; cact[k * 16 + b] = silu_f(c[i]); }
    __syncthreads();
    const int col = tid & 31, sl = tid >> 5;
    float acc[16];
#pragma unroll
    for (int b = 0; b < 16; ++b) acc[b] = 0.f;
    const float* wp = w_ada + (size_t)layer * 1024 * 3072 + (size_t)(64 * sl) * 3072 + 32 * cgp + col;
#pragma unroll 8
    for (int kk = 0; kk < 64; ++kk) {
        const float w = __builtin_nontemporal_load(wp + (size_t)kk * 3072);
        const LAS f32x4* ca = (const LAS f32x4*)(cact + (64 * sl + kk) * 16);
#pragma unroll
        for (int q = 0; q < 4; ++q) { const f32x4 cv = ca[q]; acc[4 * q] += w * cv[0]; acc[4 * q + 1] += w * cv[1]; acc[4 * q + 2] += w * cv[2]; acc[4 * q + 3] += w * cv[3]; }
    }
#pragma unroll
    for (int b = 0; b < 16; ++b) red[(sl * 16 + b) * 32 + col] = acc[b];
    __syncthreads();
    { const int b = tid >> 5; float s = 0.f;
#pragma unroll
      for (int q = 0; q < 16; ++q) s += red[(q * 16 + b) * 32 + col];
      mod[(size_t)(layer * 16 + b) * 3072 + 32 * cgp + col] = s + b_ada[layer * 3072 + 32 * cgp + col]; }
    __syncthreads();
}
struct PrepArgs { const float *c, *w_ada, *b_ada, *a_w_in, *a_w_s, *a_w_out, *b_w_in, *b_w_out; unsigned char* ws; };
__device__ __forceinline__ void prep_phase(const PrepArgs& a, LP L) {
    const int NT = 192 + 32 + 1152;
    unsigned* qctr = (unsigned*)(a.ws + WS_BAR);
    LAS int* qslot = (LAS int*)(L + LDS_BAR_OFF - 16);
    for (;;) {
        if (threadIdx.x == 0) *qslot = (int)__hip_atomic_fetch_add(qctr, 1u, __ATOMIC_RELAXED, __HIP_MEMORY_SCOPE_AGENT);
        __syncthreads();
        const int t = *qslot;
        __syncthreads();
        if (t >= NT) break;
        if (t < 192) mod_unit(a.c, a.w_ada, a.b_ada, (float*)(a.ws + WS_MOD), t, L);
        else if (t < 224) {
            const int base = (t - 192) * 4096 + threadIdx.x * 8; bf16_t* dst = (bf16_t*)(a.ws + WS_WSM);
            const int tt = (base >> 7) & 127, s0 = base & 127;
            const f32x4 x0 = *(const f32x4*)(a.a_w_s + base), x1 = *(const f32x4*)(a.a_w_s + base + 4);
            const bool z = (tt < 64) && (s0 >= 64);
            u32x4 w; w.x = cvt_pk_bf16(x0[0], x0[1]); w.y = cvt_pk_bf16(x0[2], x0[3]); w.z = cvt_pk_bf16(x1[0], x1[1]); w.w = cvt_pk_bf16(x1[2], x1[3]);
            if (z) w = (u32x4){0u, 0u, 0u, 0u};
            *(u32x4*)(dst + base) = w;
        } else {
            int q = t - 224; const float* W; bf16_t* Bt; int K, N;
            if (q < 384) { W = a.a_w_in; Bt = (bf16_t*)(a.ws + WS_WINA); K = 1024; N = 6144; }
            else if (q < 512) { q -= 384; W = a.a_w_out; Bt = (bf16_t*)(a.ws + WS_WOUTA); K = 2048; N = 1024; }
            else if (q < 1024) { q -= 512; W = a.b_w_in; Bt = (bf16_t*)(a.ws + WS_WINB); K = 1024; N = 8192; }
            else { q -= 1024; W = a.b_w_out; Bt = (bf16_t*)(a.ws + WS_WOUTB); K = 2048; N = 1024; }
            const int ntn = N / 256; transpose_tile(W, Bt, K, N, (q / ntn) * 64, (q % ntn) * 256, L, (W == a.a_w_in) ? 1 : 0);
        }
    }
}

constexpr int NR = 4;
template <bool HAS_D> __device__ __forceinline__ void hnorm_phase(const float* x, const bf16_t* dlt, const float* gain, const float* modl, bf16_t* H) {
    const int lane = threadIdx.x & 63, wave = threadIdx.x >> 6;
    for (int pr = blockIdx.x * 8 + wave; pr < T_ / NR; pr += gridDim.x * 8) {
        const int row = NR * pr, b = row >> 11;
        f32x4 v[NR][4]; u32x2 dv[NR][4]; f32x4 g4[4], sh[4], sc[4];
#pragma unroll
        for (int r = 0; r < NR; ++r)
#pragma unroll
            for (int i = 0; i < 4; ++i) { v[r][i] = __builtin_nontemporal_load((const f32x4*)(x + (size_t)(row + r) * D_ + i * 256 + lane * 4)); if (HAS_D) dv[r][i] = *(const u32x2*)(dlt + (size_t)(row + r) * D_ + i * 256 + lane * 4); }
#pragma unroll
        for (int i = 0; i < 4; ++i) { const int col = i * 256 + lane * 4; g4[i] = *(const f32x4*)(gain + col); sh[i] = *(const f32x4*)(modl + b * 3072 + col); sc[i] = *(const f32x4*)(modl + b * 3072 + 1024 + col); }
        float ss[NR];
#pragma unroll
        for (int r = 0; r < NR; ++r) ss[r] = 0.f;
#pragma unroll
        for (int r = 0; r < NR; ++r)
#pragma unroll
            for (int i = 0; i < 4; ++i) {
                if (HAS_D) { v[r][i][0] += bflo(dv[r][i].x); v[r][i][1] += bfhi(dv[r][i].x); v[r][i][2] += bflo(dv[r][i].y); v[r][i][3] += bfhi(dv[r][i].y); }
                ss[r] += v[r][i][0] * v[r][i][0] + v[r][i][1] * v[r][i][1] + v[r][i][2] * v[r][i][2] + v[r][i][3] * v[r][i][3];
            }
#pragma unroll
        for (int o = 32; o >= 1; o >>= 1) {
#pragma unroll
            for (int r = 0; r < NR; ++r) ss[r] += __shfl_xor(ss[r], o); }
#pragma unroll
        for (int r = 0; r < NR; ++r) {
            const float rstd = __builtin_amdgcn_rsqf(ss[r] * (1.0f / 1024.0f) + EPS_);
#pragma unroll
            for (int i = 0; i < 4; ++i) {
                const f32x4 h = v[r][i] * rstd * g4[i] * (sc[i] + 1.0f) + sh[i];
                u32x2 w; w.x = cvt_pk_bf16(h[0], h[1]); w.y = cvt_pk_bf16(h[2], h[3]);
                *(u32x2*)(H + (size_t)(row + r) * D_ + i * 256 + lane * 4) = w;
            }
        }
    }
}
__device__ __forceinline__ void final_norm_phase(const float* x, const bf16_t* dlt, float* xo, const float* gain) {
    const int lane = threadIdx.x & 63, wave = threadIdx.x >> 6;
    f32x4 g4[4];
#pragma unroll
    for (int i = 0; i < 4; ++i) g4[i] = *(const f32x4*)(gain + i * 256 + lane * 4);
    for (int pr = blockIdx.x * 8 + wave; pr < T_ / NR; pr += gridDim.x * 8) {
        const int row = NR * pr;
        f32x4 v[NR][4]; u32x2 dv[NR][4];
#pragma unroll
        for (int r = 0; r < NR; ++r)
#pragma unroll
            for (int i = 0; i < 4; ++i) { v[r][i] = __builtin_nontemporal_load((const f32x4*)(x + (size_t)(row + r) * D_ + i * 256 + lane * 4)); dv[r][i] = *(const u32x2*)(dlt + (size_t)(row + r) * D_ + i * 256 + lane * 4); }
        float ss[NR];
#pragma unroll
        for (int r = 0; r < NR; ++r) ss[r] = 0.f;
#pragma unroll
        for (int r = 0; r < NR; ++r)
#pragma unroll
            for (int i = 0; i < 4; ++i) {
                v[r][i][0] += bflo(dv[r][i].x); v[r][i][1] += bfhi(dv[r][i].x); v[r][i][2] += bflo(dv[r][i].y); v[r][i][3] += bfhi(dv[r][i].y);
                ss[r] += v[r][i][0] * v[r][i][0] + v[r][i][1] * v[r][i][1] + v[r][i][2] * v[r][i][2] + v[r][i][3] * v[r][i][3];
            }
#pragma unroll
        for (int o = 32; o >= 1; o >>= 1) {
#pragma unroll
            for (int r = 0; r < NR; ++r) ss[r] += __shfl_xor(ss[r], o); }
#pragma unroll
        for (int r = 0; r < NR; ++r) {
            const float rstd = __builtin_amdgcn_rsqf(ss[r] * (1.0f / 1024.0f) + EPS_);
#pragma unroll
            for (int i = 0; i < 4; ++i) __builtin_nontemporal_store(v[r][i] * rstd * g4[i], (f32x4*)(xo + (size_t)(row + r) * D_ + i * 256 + lane * 4));
        }
    }
}

constexpr int SP_WS = 0, SP_WS_RS = 272, SP_ST = 128 * 272, SP_VN = SP_ST + 8 * 128 * 8, SP_VN_RS = 80, SP_VN_W = 128 * 80, SP_BS = SP_VN + 8 * SP_VN_W, SP_END = SP_BS + 512;
static_assert(SP_END <= LDS_BAR_OFF, "spatial lds");
__device__ __forceinline__ void sp_loadv(const bf16_t* V, int nb, int g, int w, int lane, u32x4 (&vr)[8]) {
#pragma unroll
    for (int i = 0; i < 8; ++i) vr[i] = *(const u32x4*)(V + (size_t)(nb * 128 + (lane >> 2) + 16 * i) * DI_ + g * 256 + 32 * w + 8 * (lane & 3));
}
template <int SMODE> __device__ __forceinline__ void spatial_phase(LP L, const bf16_t* U, bf16_t* Y, const bf16_t* V, const bf16_t* G, const f32x2* vst, const bf16_t* wsm, const float* b_s, const float* ln_gain, const float* ln_bias) {
    const int tid = threadIdx.x, lane = tid & 63, w = tid >> 6, fr = lane & 15, fq = lane >> 4, tq = fr >> 2, tp = fr & 3;
    const int vG = (int)gridDim.x & ~7;
    if ((int)blockIdx.x >= vG) return;
    const int g = blockIdx.x & 7, nb0 = blockIdx.x >> 3, nbs = vG >> 3;
    const int nU = (256 - nb0 + nbs - 1) / nbs;
#pragma unroll
    for (int i = 0; i < 4; ++i) { const int id = tid + 512 * i, r = id >> 4, c = id & 15; *(LAS u32x4*)(L + SP_WS + r * SP_WS_RS + c * 16) = *(const u32x4*)(wsm + (size_t)(g * 128 + r) * 128 + c * 8); }
    if (tid < 128) *(LAS float*)(L + SP_BS + tid * 4) = b_s[g * 128 + tid];
    const int dch = g * 256 + 32 * w + 8 * (lane & 3);
    const f32x4 g0 = *(const f32x4*)(ln_gain + dch), g1 = *(const f32x4*)(ln_gain + dch + 4), b0 = *(const f32x4*)(ln_bias + dch), b1 = *(const f32x4*)(ln_bias + dch + 4);
    LP VN = L + SP_VN + w * SP_VN_W;
    for (int i0 = 0; i0 < nU; i0 += 8) {
        const int nbat = (nU - i0) < 8 ? (nU - i0) : 8;
        __syncthreads();
        for (int rr = tid >> 2; rr < nbat * 128; rr += 128) {
            const int iu = rr >> 7, s = rr & 127, nb = nb0 + nbs * (i0 + iu);
            const f32x2* p = vst + (size_t)(8 * (tid & 3)) * T_ + (nb * 128 + s);
            float s1 = 0.f, s2 = 0.f;
#pragma unroll
            for (int q = 0; q < 8; ++q) { const f32x2 t = p[(size_t)q * T_]; s1 += t.x; s2 += t.y; }
            s1 += __shfl_xor(s1, 1); s1 += __shfl_xor(s1, 2); s2 += __shfl_xor(s2, 1); s2 += __shfl_xor(s2, 2);
            const float mu = s1 * (1.0f / 2048.0f), var = s2 * (1.0f / 2048.0f) - mu * mu;
            if ((tid & 3) == 0) *(LAS f32x2*)(L + SP_ST + rr * 8) = (f32x2){mu, __builtin_amdgcn_rsqf(var + EPS_)};
        }
        __syncthreads();
        u32x4 vr[8];
        sp_loadv(V, nb0 + nbs * i0, g, w, lane, vr);
        for (int iu = 0; iu < nbat; ++iu) {
            const int nb = nb0 + nbs * (i0 + iu);
#pragma unroll
            for (int i = 0; i < 8; ++i) {
                const int s = (lane >> 2) + 16 * i; const u32x4 raw = vr[i];
                const f32x2 ms = *(const LAS f32x2*)(L + SP_ST + (iu * 128 + s) * 8);
                float v[8] = {bflo(raw.x), bfhi(raw.x), bflo(raw.y), bfhi(raw.y), bflo(raw.z), bfhi(raw.z), bflo(raw.w), bfhi(raw.w)};
#pragma unroll
                for (int j = 0; j < 4; ++j) { v[j] = (v[j] - ms.x) * ms.y * g0[j] + b0[j]; v[4 + j] = (v[4 + j] - ms.x) * ms.y * g1[j] + b1[j]; }
                u32x4 o; o.x = cvt_pk_bf16(v[0], v[1]); o.y = cvt_pk_bf16(v[2], v[3]); o.z = cvt_pk_bf16(v[4], v[5]); o.w = cvt_pk_bf16(v[6], v[7]);
                *(LAS u32x2*)(VN + s * SP_VN_RS + 8 * (lane & 3)) = (u32x2){o.x, o.y};
                *(LAS u32x2*)(VN + s * SP_VN_RS + 32 + 8 * (lane & 3)) = (u32x2){o.z, o.w};
            }
            if (iu + 1 < nbat) sp_loadv(V, nb + nbs, g, w, lane, vr);
            f32x4 acc[2][8];
#pragma unroll
            for (int dt = 0; dt < 2; ++dt)
#pragma unroll
                for (int tt = 0; tt < 8; ++tt) acc[dt][tt] = (f32x4){0.f, 0.f, 0.f, 0.f};
            bf16x8 af[2][4];
#pragma unroll
            for (int dt = 0; dt < 2; ++dt)
#pragma unroll
                for (int ks = 0; ks < 4; ++ks) { LP p = VN + (32 * ks + 8 * fq + tq) * SP_VN_RS + 32 * dt + 8 * tp; af[dt][ks] = mk8(trrd(p), trrd(p + 4 * SP_VN_RS)); }
#pragma unroll
            for (int tt = 0; tt < 8; ++tt) {
#pragma unroll
                for (int ks = 0; ks < 4; ++ks) {
                    if (tt < 4 && ks >= 2) continue;
                    const bf16x8 bfr = *(const LAS bf16x8*)(L + SP_WS + (16 * tt + fr) * SP_WS_RS + (32 * ks + 8 * fq) * 2);
                    acc[0][tt] = MFMA16(af[0][ks], bfr, acc[0][tt]); acc[1][tt] = MFMA16(af[1][ks], bfr, acc[1][tt]);
                }
            }
#pragma unroll
            for (int tt = 0; tt < 8; ++tt) {
                const int t = 16 * tt + fr; const float bs = *(const LAS float*)(L + SP_BS + t * 4);
                const size_t off = (size_t)(nb * 128 + t) * DI_ + g * 256 + 32 * w + 8 * fq;
                const f32x4 a0 = acc[0][tt], a1 = acc[1][tt];
                u32x4 o; o.x = cvt_pk_bf16(a0[0] + bs, a0[1] + bs); o.y = cvt_pk_bf16(a0[2] + bs, a0[3] + bs); o.z = cvt_pk_bf16(a1[0] + bs, a1[1] + bs); o.w = cvt_pk_bf16(a1[2] + bs, a1[3] + bs);
                *(u32x4*)(Y + off) = o;
            }
        }
    }
}

constexpr int HG_QIN = 0, HG_QIN_RS = 272, HG_KIN = 64 * 272, HG_KIN_RS = 288, HG_IS = HG_KIN + 64 * 288, HG_IS_RS = 288, HG_IS_SZ = 64 * 288, HG_P = HG_IS + 2 * HG_IS_SZ, HG_P_RS = 144,
              HG_ST = HG_P + 64 * 144, HG_ST_RS = 272, HG_AB = HG_ST + 128 * 272, HG_TOT = HG_AB + 64 * 512, HG_ER = HG_TOT + 2048, HG_DEC = HG_ER + 512, HG_E2 = HG_DEC + 512, HG_SSQ = HG_E2 + 512, HG_GN = HG_SSQ + 512, HG_END = HG_GN + 512;
static_assert(HG_END <= LDS_BAR_OFF, "hgrn lds");
struct HgCtx { LP L; const bf16_t* Q; bf16_t* O; const bf16_t* LF; const bf16_t* I; const float* gn_gain; size_t ubase; };
__device__ __forceinline__ void hg_load_f(const HgCtx& x, int c, u32x4 (&lr)[2]) {
    const int tid = threadIdx.x;
#pragma unroll
    for (int i = 0; i < 2; ++i) { const int id = tid + 512 * i, r = id >> 4, cp = id & 15; lr[i] = __builtin_nontemporal_load((const u32x4*)(x.LF + x.ubase + (size_t)(64 * c + r) * DI_ + cp * 8)); }
}
__device__ __forceinline__ void hg_load_q(const HgCtx& x, int c, u32x4 (&qr)[2]) {
    const int tid = threadIdx.x;
#pragma unroll
    for (int i = 0; i < 2; ++i) { const int id = tid + 512 * i, r = id >> 4, cp = id & 15; qr[i] = __builtin_nontemporal_load((const u32x4*)(x.Q + x.ubase + (size_t)(64 * c + r) * DI_ + cp * 8)); }
}
__device__ __forceinline__ void hg_load_i(const HgCtx& x, int c, u32x4 (&ir)[2]) {
    const int tid = threadIdx.x;
#pragma unroll
    for (int i = 0; i < 2; ++i) { const int id = tid + 512 * i, r = id >> 4, cp = id & 15; ir[i] = __builtin_nontemporal_load((const u32x4*)(x.I + x.ubase + (size_t)(64 * c + r) * DI_ + cp * 8)); }
}
__device__ __forceinline__ void hg_s0(const HgCtx& x, int buf, const u32x4 (&lr)[2], const u32x4 (&ir)[2]) {
    LP L = x.L; const int tid = threadIdx.x;
#pragma unroll
    for (int i = 0; i < 2; ++i) {
        const int id = tid + 512 * i, r = id >> 4, cp = id & 15;
        const u32x4 lf = lr[i];
        *(LAS f32x4*)(L + HG_AB + r * 512 + cp * 32) = (f32x4){bflo(lf.x), bfhi(lf.x), bflo(lf.y), bfhi(lf.y)};
        *(LAS f32x4*)(L + HG_AB + r * 512 + cp * 32 + 16) = (f32x4){bflo(lf.z), bfhi(lf.z), bflo(lf.w), bfhi(lf.w)};
        *(LAS u32x4*)(L + HG_IS + buf * HG_IS_SZ + r * HG_IS_RS + cp * 16) = ir[i];
    }
}
__device__ __forceinline__ void hg_s1(const HgCtx& x) {
    LP L = x.L; const int tid = threadIdx.x, k = tid & 127, seg = tid >> 7;
    float run = 0.f;
#pragma unroll
    for (int h8 = 0; h8 < 2; ++h8) {
        float a[8];
#pragma unroll
        for (int j = 0; j < 8; ++j) a[j] = *(const LAS float*)(L + HG_AB + (16 * seg + 8 * h8 + j) * 512 + k * 4);
#pragma unroll
        for (int j = 0; j < 8; ++j) { run += a[j]; *(LAS float*)(L + HG_AB + (16 * seg + 8 * h8 + j) * 512 + k * 4) = run; }
        __builtin_amdgcn_sched_barrier(0);
    }
    *(LAS float*)(L + HG_TOT + (seg * 128 + k) * 4) = run;
}
__device__ __forceinline__ void hg_s2(const HgCtx& x, const u32x4 (&qr)[2], const u32x4 (&lr)[2]) {
    LP L = x.L; const int tid = threadIdx.x;
#pragma unroll
    for (int i = 0; i < 2; ++i) {
        const int id = tid + 512 * i, r = id >> 4, cp = id & 15, sg = r >> 4;
        const float m0 = sg > 0 ? 0.f : -1.f, m1 = sg > 1 ? 0.f : -1.f, m2 = sg > 2 ? 1.f : 0.f;
        const u32x4 lf = lr[i], qq = qr[i];
        const unsigned lw[4] = {lf.x, lf.y, lf.z, lf.w}, qw[4] = {qq.x, qq.y, qq.z, qq.w};
        unsigned oq[4], ok[4];
#pragma unroll
        for (int pq = 0; pq < 4; ++pq) {
            const f32x2 av = *(const LAS f32x2*)(L + HG_AB + r * 512 + cp * 32 + 8 * pq);
            const f32x2 t0 = *(const LAS f32x2*)(L + HG_TOT + (8 * cp + 2 * pq) * 4), t1 = *(const LAS f32x2*)(L + HG_TOT + (128 + 8 * cp + 2 * pq) * 4), t2 = *(const LAS f32x2*)(L + HG_TOT + (256 + 8 * cp + 2 * pq) * 4);
            const f32x2 d = av + t0 * m0 + t1 * m1 + t2 * m2;
            const unsigned lww = lw[pq], qww = qw[pq];
            const f32x2 lfv = (f32x2){bflo(lww), bfhi(lww)}, qv = (f32x2){bflo(qww), bfhi(qww)};
            const f32x2 e1 = ex2_2(d), e2 = ex2_2(-d), ef = ex2_2(lfv);
            const f32x2 qi = qv * e1, ki = (1.0f - ef) * e2;
            oq[pq] = cvt_pk_bf16(qi.x, qi.y); ok[pq] = cvt_pk_bf16(ki.x, ki.y);
        }
        *(LAS u32x4*)(L + HG_QIN + r * HG_QIN_RS + cp * 16) = (u32x4){oq[0], oq[1], oq[2], oq[3]};
        *(LAS u32x4*)(L + HG_KIN + r * HG_KIN_RS + cp * 16) = (u32x4){ok[0], ok[1], ok[2], ok[3]};
        __builtin_amdgcn_sched_barrier(0);
    }
    if (tid < 128) {
        const float t0 = *(const LAS float*)(L + HG_TOT + tid * 4), t1 = *(const LAS float*)(L + HG_TOT + (128 + tid) * 4), t2 = *(const LAS float*)(L + HG_TOT + (256 + tid) * 4), t3 = *(const LAS float*)(L + HG_TOT + (384 + tid) * 4);
        const float aref = t0 + t1, alast = aref + t2 + t3;
        *(LAS float*)(L + HG_ER + tid * 4) = __builtin_amdgcn_exp2f(aref); *(LAS float*)(L + HG_DEC + tid * 4) = __builtin_amdgcn_exp2f(alast); *(LAS float*)(L + HG_E2 + tid * 4) = __builtin_amdgcn_exp2f(alast - aref);
    }
}
__device__ __forceinline__ void hg_s3(const HgCtx& x, const f32x4 (&st)[8]) {
    LP L = x.L; const int tid = threadIdx.x, lane = tid & 63, w = tid >> 6, fr = lane & 15, fq = lane >> 4;
    const int ti = w >> 1;
    bf16x8 qb[4];
#pragma unroll
    for (int ks = 0; ks < 4; ++ks) qb[ks] = *(const LAS bf16x8*)(L + HG_QIN + (16 * ti + fr) * HG_QIN_RS + (32 * ks + 8 * fq) * 2);
#pragma unroll
    for (int e2 = 0; e2 < 2; ++e2) {
        const int sj = 2 * (w & 1) + e2;
        f32x4 sc = (f32x4){0.f, 0.f, 0.f, 0.f};
        if (sj <= ti) {
#pragma unroll
            for (int ks = 0; ks < 4; ++ks) { const bf16x8 ka = *(const LAS bf16x8*)(L + HG_KIN + (16 * sj + fr) * HG_KIN_RS + (32 * ks + 8 * fq) * 2); sc = MFMA16(ka, qb[ks], sc); }
        }
        const int t = 16 * ti + fr, s0 = 16 * sj + 4 * fq;
        u32x2 o; o.x = cvt_pk_bf16(s0 <= t ? sc[0] : 0.f, s0 + 1 <= t ? sc[1] : 0.f); o.y = cvt_pk_bf16(s0 + 2 <= t ? sc[2] : 0.f, s0 + 3 <= t ? sc[3] : 0.f);
        *(LAS u32x2*)(L + HG_P + t * HG_P_RS + s0 * 2) = o;
    }
    const f32x4 er = *(const LAS f32x4*)(L + HG_ER + (16 * w + 4 * fq) * 4);
#pragma unroll
    for (int vt = 0; vt < 8; ++vt) {
        const f32x4 sv = st[vt] * er; u32x2 o; o.x = cvt_pk_bf16(sv[0], sv[1]); o.y = cvt_pk_bf16(sv[2], sv[3]);
        *(LAS u32x2*)(L + HG_ST + (16 * vt + fr) * HG_ST_RS + (16 * w + 4 * fq) * 2) = o;
    }
}
__device__ __forceinline__ void hg_s45(const HgCtx& x, int buf, f32x4 (&st)[8], f32x4 (&oacc)[4]) {
    LP L = x.L; const int tid = threadIdx.x, lane = tid & 63, w = tid >> 6, fr = lane & 15, fq = lane >> 4, tq = fr >> 2, tp = fr & 3;
    const int tt = w & 3, vh = w >> 2;
    LP IS = L + HG_IS + buf * HG_IS_SZ;
    {
#pragma unroll
        for (int vt = 0; vt < 4; ++vt) oacc[vt] = (f32x4){0.f, 0.f, 0.f, 0.f};
#pragma unroll
        for (int ks = 0; ks < 2; ++ks) {
            if (ks == 1 && tt < 2) continue;
            const bf16x8 pb = *(const LAS bf16x8*)(L + HG_P + (16 * tt + fr) * HG_P_RS + (32 * ks + 8 * fq) * 2);
#pragma unroll
            for (int vp = 0; vp < 4; vp += 2) {
                LP p0 = IS + (32 * ks + 8 * fq + tq) * HG_IS_RS + (16 * (4 * vh + vp)) * 2 + 8 * tp;
                const bf16x8 i0 = mk8(trrd(p0), trrd(p0 + 4 * HG_IS_RS)), i1 = mk8(trrd(p0 + 32), trrd(p0 + 32 + 4 * HG_IS_RS));
                oacc[vp] = MFMA16(i0, pb, oacc[vp]); oacc[vp + 1] = MFMA16(i1, pb, oacc[vp + 1]);
            }
        }
#pragma unroll
        for (int ks = 0; ks < 4; ++ks) {
            const bf16x8 qb = *(const LAS bf16x8*)(L + HG_QIN + (16 * tt + fr) * HG_QIN_RS + (32 * ks + 8 * fq) * 2);
#pragma unroll
            for (int vp = 0; vp < 4; vp += 2) {
                const bf16x8 s0 = *(const LAS bf16x8*)(L + HG_ST + (16 * (4 * vh + vp) + fr) * HG_ST_RS + (32 * ks + 8 * fq) * 2), s1 = *(const LAS bf16x8*)(L + HG_ST + (16 * (4 * vh + vp + 1) + fr) * HG_ST_RS + (32 * ks + 8 * fq) * 2);
                oacc[vp] = MFMA16(s0, qb, oacc[vp]); oacc[vp + 1] = MFMA16(s1, qb, oacc[vp + 1]);
            }
        }
        float ss = 0.f;
#pragma unroll
        for (int vt = 0; vt < 4; ++vt) ss += oacc[vt][0] * oacc[vt][0] + oacc[vt][1] * oacc[vt][1] + oacc[vt][2] * oacc[vt][2] + oacc[vt][3] * oacc[vt][3];
        ss += __shfl_xor(ss, 16); ss += __shfl_xor(ss, 32);
        if (fq == 0) *(LAS float*)(L + HG_SSQ + (vh * 64 + 16 * tt + fr) * 4) = ss;
    }
    __builtin_amdgcn_sched_barrier(0);
    {
        bf16x8 ka[2];
#pragma unroll
        for (int ks = 0; ks < 2; ++ks) { LP p = L + HG_KIN + (32 * ks + 8 * fq + tq) * HG_KIN_RS + (16 * w) * 2 + 8 * tp; ka[ks] = mk8(trrd(p), trrd(p + 4 * HG_KIN_RS)); }
        const f32x4 dc = *(const LAS f32x4*)(L + HG_DEC + (16 * w + 4 * fq) * 4), e2v = *(const LAS f32x4*)(L + HG_E2 + (16 * w + 4 * fq) * 4);
#pragma unroll
        for (int hv = 0; hv < 4; ++hv) {
            f32x4 tacc[2];
#pragma unroll
            for (int j = 0; j < 2; ++j) tacc[j] = (f32x4){0.f, 0.f, 0.f, 0.f};
#pragma unroll
            for (int ks = 0; ks < 2; ++ks) {
                bf16x8 ib[2];
#pragma unroll
                for (int j = 0; j < 2; ++j) { LP p = IS + (32 * ks + 8 * fq + tq) * HG_IS_RS + (16 * (2 * hv + j)) * 2 + 8 * tp; ib[j] = mk8(trrd(p), trrd(p + 4 * HG_IS_RS)); }
#pragma unroll
                for (int j = 0; j < 2; ++j) tacc[j] = MFMA16(ka[ks], ib[j], tacc[j]);
            }
#pragma unroll
            for (int j = 0; j < 2; ++j) st[2 * hv + j] = dc * st[2 * hv + j] + e2v * tacc[j];
        }
    }
}
__device__ __forceinline__ void hg_s6(const HgCtx& x, int c, const f32x4 (&oacc)[4]) {
    LP L = x.L; const int tid = threadIdx.x, lane = tid & 63, w = tid >> 6, fr = lane & 15, fq = lane >> 4;
    const int tt = w & 3, vh = w >> 2, t = 16 * tt + fr;
    const size_t cbase = x.ubase + (size_t)(64 * c) * DI_;
    const float tot = *(const LAS float*)(L + HG_SSQ + t * 4) + *(const LAS float*)(L + HG_SSQ + (64 + t) * 4);
    const float rstd = __builtin_amdgcn_rsqf(tot * (1.0f / 128.0f) + EPS_);
#pragma unroll
    for (int vt = 0; vt < 4; ++vt) {
        const int v0 = 64 * vh + 16 * vt + 4 * fq; const f32x4 gn = *(const LAS f32x4*)(L + HG_GN + v0 * 4); const f32x4 y = oacc[vt] * rstd * gn;
        u32x2 o; o.x = cvt_pk_bf16(y[0], y[1]); o.y = cvt_pk_bf16(y[2], y[3]);
        *(u32x2*)(x.O + cbase + (size_t)t * DI_ + v0) = o;
    }
}
__device__ __forceinline__ void hg_trip(const HgCtx& x, int c, u32x4 (&qn)[2], u32x4 (&ln)[2], u32x4 (&in)[2], f32x4 (&st)[8]) {
    const bool more = (c + 1 < 32);
    f32x4 oacc[4];
    if (more) { hg_s0(x, (c + 1) & 1, ln, in); if (c + 2 < 32) hg_load_i(x, c + 2, in); }
    __builtin_amdgcn_sched_barrier(0);
    hg_s3(x, st);
    lds_barrier();
    if (more) hg_s1(x);
    __builtin_amdgcn_sched_barrier(0);
    hg_s45(x, c & 1, st, oacc);
    lds_barrier();
    hg_s6(x, c, oacc);
    __builtin_amdgcn_sched_barrier(0);
    if (more) { hg_s2(x, qn, ln); if (c + 2 < 32) hg_load_q(x, c + 2, qn); if (c + 3 < 32) hg_load_f(x, c + 3, ln); }
    lds_barrier();
}
__device__ __forceinline__ void hgrn_phase(LP L, const bf16_t* Q, bf16_t* O, const bf16_t* LF, const bf16_t* I, const float* gn_gain) {
    if (threadIdx.x < 128) *(LAS float*)(L + HG_GN + threadIdx.x * 4) = gn_gain[threadIdx.x];
    __syncthreads();
    for (int unit = blockIdx.x; unit < 256; unit += gridDim.x) {
        const int b = unit >> 4, h = unit & 15;
        HgCtx x{L, Q, O, LF, I, gn_gain, (size_t)b * SEQ_ * DI_ + h * 128};
        f32x4 st[8];
#pragma unroll
        for (int i = 0; i < 8; ++i) st[i] = (f32x4){0.f, 0.f, 0.f, 0.f};
        u32x4 qq[2], la[2], lb[2], ii[2];
        hg_load_f(x, 0, la); hg_load_i(x, 0, ii); hg_load_q(x, 0, qq); hg_load_f(x, 1, lb);
        hg_s0(x, 0, la, ii); hg_load_i(x, 1, ii); lds_barrier(); hg_s1(x); lds_barrier(); hg_s2(x, qq, la); hg_load_q(x, 1, qq); hg_load_f(x, 2, la); lds_barrier();
        for (int c = 0; c < 32; c += 2) { hg_trip(x, c, qq, lb, ii, st); hg_trip(x, c + 1, qq, la, ii, st); }
    }
}

struct Params { const float* in[16]; float* out; unsigned char* ws; int ph_lo, ph_hi; };
__global__ void __launch_bounds__(512) mega_fwd(Params p) {
    extern __shared__ __attribute__((aligned(16))) unsigned char lds_raw[];
    LP L = (LP)lds_raw;
    cg::grid_group grid = cg::this_grid();
    unsigned char* ws = p.ws;
    const float* x = p.in[0];
    float* mod = (float*)(ws + WS_MOD);
    bf16_t* H = (bf16_t*)(ws + WS_H); bf16_t* P0 = (bf16_t*)(ws + WS_P0); bf16_t* P1 = (bf16_t*)(ws + WS_P1); bf16_t* P2 = (bf16_t*)(ws + WS_P2);
    const int G = gridDim.x, bx = blockIdx.x;
    bf16_t* D0 = (bf16_t*)p.out;
    volatile LAS unsigned* bst = (volatile LAS unsigned*)(L + LDS_BAR_OFF);
    if (threadIdx.x < 4) bst[threadIdx.x] = 0u;
    __syncthreads();
    XcdBarrier bar = xcd_barrier_post((unsigned*)(ws + WS_BAR), bst);
    if (p.ph_hi - p.ph_lo > 1) grid.sync();
    const int lo = p.ph_lo, hi = p.ph_hi;
#define IN(k) (lo <= (k) && (k) < hi)
#define SEAM(k) do { if (lo <= (k) && (k) + 1 < hi) xcd_barrier(bar); } while (0)
    if (IN(0)) { PrepArgs a{p.in[1], p.in[3], p.in[4], p.in[5], p.in[8], p.in[10], p.in[11], p.in[14], ws}; prep_phase(a, L); }
    SEAM(0);
    if (IN(1)) hnorm_phase<false>(x, nullptr, p.in[2], mod, H);
    SEAM(1);
    if (IN(2)) { pg8::Gemm g{H, (const bf16_t*)(ws + WS_WINA), T_, 2048, 1024}; pg8::StaticOrder S; S.init(T_, 2048, G, bx); EpiV E{P1, (f32x2*)(ws + WS_VST)};
                 pg8::gemm_phase<EpiV, pg8::StaticOrder>(L, g, S, E, nullptr); }
    SEAM(2);
    if (IN(3)) spatial_phase<1>(L, P1, P1, P1, P1, (const f32x2*)(ws + WS_VST), (const bf16_t*)(ws + WS_WSM), p.in[9], p.in[6], p.in[7]);
    if (IN(3)) { xcd_barrier(bar);
                 pg8::Gemm g{H, (const bf16_t*)(ws + WS_WINA) + (size_t)2048 * 1024, T_, 4096, 1024}; pg8::StaticOrder S; S.init(T_, 4096, G, bx); EpiUG E{P1, P0};
                 pg8::gemm_phase<EpiUG, pg8::StaticOrder>(L, g, S, E, nullptr); }
    SEAM(3);
    if (IN(4)) { pg8::Gemm g{P0, (const bf16_t*)(ws + WS_WOUTA), T_, 1024, 2048}; pg8::StaticOrder S; S.init(T_, 1024, G, bx); EpiDelta<false> E{nullptr, D0, mod + 2048};
                 pg8::gemm_phase<EpiDelta<false>, pg8::StaticOrder>(L, g, S, E, nullptr); }
    SEAM(4);
    if (IN(5)) hnorm_phase<true>(x, D0, p.in[2] + 1024, mod + 16 * 3072, H);
    SEAM(5);
    if (IN(6)) { pg8::Gemm g{H, (const bf16_t*)(ws + WS_WINB), T_, 6144, 1024}; pg8::StaticOrder S; S.init(T_, 6144, G, bx); EpiB1 E{P0, P1, P2, p.in[12]};
                 pg8::gemm_phase<EpiB1, pg8::StaticOrder>(L, g, S, E, nullptr); }
    SEAM(6);
    if (IN(7)) hgrn_phase(L, P0, P0, P1, P2, p.in[13]);
    SEAM(7);
    if (IN(8)) { pg8::Gemm g{H, (const bf16_t*)(ws + WS_WINB) + (size_t)6144 * 1024, T_, 2048, 1024}; pg8::StaticOrder S; S.init(T_, 2048, G, bx); EpiGate E{P0};
                 pg8::gemm_phase<EpiGate, pg8::StaticOrder>(L, g, S, E, nullptr); }
    SEAM(8);
    if (IN(9)) { pg8::Gemm g{P0, (const bf16_t*)(ws + WS_WOUTB), T_, 1024, 2048}; pg8::StaticOrder S; S.init(T_, 1024, G, bx); EpiDelta<true> E{D0, H, mod + 16 * 3072 + 2048};
                 pg8::gemm_phase<EpiDelta<true>, pg8::StaticOrder>(L, g, S, E, nullptr); }
    SEAM(9);
    if (IN(10)) final_norm_phase(x, H, p.out, p.in[15]);
#undef IN
#undef SEAM
}

extern "C" void kernel_launch(void* const* d_in, const int* in_sizes, int n_in, void* d_out, int out_size, void* d_ws, size_t ws_size, hipStream_t stream) {
    static int grid_blocks = 0;
    if (!grid_blocks) {
        if (n_in != 16 || ws_size < WS_END) { fprintf(stderr, "kernel_launch: need 16 inputs and >= %zu bytes of workspace; got %d, %zu\n", (size_t)WS_END, n_in, ws_size); grid_blocks = -1; return; }
        int dev = 0, cus = 0, per_cu = 0;
        hipGetDevice(&dev);
        hipDeviceGetAttribute(&cus, hipDeviceAttributeMultiprocessorCount, dev);
        if (hipFuncSetAttribute((const void*)mega_fwd, hipFuncAttributeMaxDynamicSharedMemorySize, LDS_BYTES) != hipSuccess) { fprintf(stderr, "kernel_launch: hipFuncSetAttribute failed\n"); }
        if (hipOccupancyMaxActiveBlocksPerMultiprocessor(&per_cu, (const void*)mega_fwd, 512, LDS_BYTES) != hipSuccess || per_cu < 1) { fprintf(stderr, "kernel_launch: occupancy query failed (%d)\n", per_cu); per_cu = 1; }
        (void)hipGetLastError();
        grid_blocks = cus * per_cu;
        if (grid_blocks > 256) grid_blocks = 256;
    }
    if (grid_blocks < 0) return;
    if (hipMemsetAsync((char*)d_ws + WS_BAR, 0, XCD_BAR_WORDS * sizeof(unsigned), stream) != hipSuccess) { fprintf(stderr, "kernel_launch: memset of barrier words failed\n"); return; }
    Params p{};
    for (int i = 0; i < 16; ++i) p.in[i] = (const float*)d_in[i];
    p.out = (float*)d_out; p.ws = (unsigned char*)d_ws;
    p.ph_lo = 0; p.ph_hi = NPHASE;
    void* args[] = {&p};
    hipError_t e = hipLaunchCooperativeKernel((const void*)mega_fwd, dim3(grid_blocks), dim3(512), args, LDS_BYTES, stream);
    if (e != hipSuccess) fprintf(stderr, "cooperative launch failed: %s (grid %d)\n", hipGetErrorString(e), grid_blocks);
}
```

```cpp
#include <hip/hip_runtime.h>
#include <hip/hip_cooperative_groups.h>
#include <cstdio>
namespace cg = cooperative_groups;
namespace pg8 {
#define PG8_LAS __attribute__((address_space(3)))
typedef unsigned short bf16_t;
typedef short bf16x8 __attribute__((ext_vector_type(8)));
typedef float f32x4 __attribute__((ext_vector_type(4)));
typedef unsigned u32x4 __attribute__((ext_vector_type(4)));
constexpr int BM = 256, BK = 64, HALF = 128, HTB = HALF * BK * 2  , STAGE_BYTES = 8 * HTB, NXCD = 8, WGM = 4;

__host__ __device__ __forceinline__ int lds_byte(int r, int c) { const int st = (r >> 4) * 2 + (c >> 5), rr = r & 15, cc = c & 31, ob = rr * 64 + cc * 2; return st * 1024 + (ob ^ (((ob >> 9) & 1) << 5)); }
__host__ __device__ __forceinline__ void stage_rc(int b, int& R, int& C) { const int st = b / 1024, sb = b % 1024, swz = sb ^ (((sb >> 9) & 1) << 5); R = (st >> 1) * 16 + swz / 64; C = (st & 1) * 32 + (swz % 64) / 2; }
__host__ __device__ __forceinline__ int perm32(int rho) { const int n = rho >> 4, i = rho & 15; return 8 * (i >> 2) + 4 * n + (i & 3); }

struct Unit { int pm, pn; };
struct Gemm { const bf16_t* A; const bf16_t* Bt; int M, N, K; };

struct StaticOrder {
    int nM, nN, nwg, G, c;
    __host__ __device__ void init(int M, int N, int G_, int c_) { nM = M / BM; nN = N / BM; nwg = nM * nN; G = G_; c = c_; }
    __host__ __device__ bool next(int i, Unit& u) const {
        const long L = (long)i * G + c; if (L >= nwg) return false;
        int wgid = (int)L; { const int q = nwg / NXCD, r = nwg % NXCD, xcd = wgid % NXCD, off = wgid / NXCD; wgid = (xcd < r ? xcd * (q + 1) : r * (q + 1) + (xcd - r) * q) + off; }
        const int nig = WGM * nN, gid = wgid / nig, fm = gid * WGM, gsz = (nM - fm) < WGM ? (nM - fm) : WGM;
        u.pm = fm + ((wgid % nig) % gsz); u.pn = (wgid % nig) / gsz; return true;
    }
    __device__ __forceinline__ void a_ready(const Unit&) const {}
    __device__ __forceinline__ void done(const Unit&) const {}
};
__device__ __forceinline__ unsigned cvt_pk_bf16(float lo, float hi) { unsigned r; asm volatile("v_cvt_pk_bf16_f32 %0, %1, %2" : "=v"(r) : "v"(lo), "v"(hi)); return r; }
typedef float f32x2 __attribute__((ext_vector_type(2)));
template <class Epi, class Sched, bool STAMP = false>
__device__ __forceinline__ void gemm_phase(PG8_LAS unsigned char* lds, const Gemm g, const Sched& S, const Epi& E, unsigned long long* stamps) {
    const int tid = threadIdx.x, wid = __builtin_amdgcn_readfirstlane(tid >> 6), lane = tid & 63, wr = wid >> 2, wc = wid & 3, fr = lane & 15, fq = lane >> 4;
    const int K = g.K, nt = K / BK;
    int ts_lo = 0, ts_hi = 0, nts = 0; const unsigned long long rt_entry = STAMP ? (unsigned long long)wall_clock64() : 0ull;
#define PG8_STAMP() do { if (STAMP && wid == 0 && nts < 64) { const unsigned long long _c = (unsigned long long)clock64(); \
        ts_lo = (lane == nts) ? (int)(unsigned)_c : ts_lo; ts_hi = (lane == nts) ? (int)(unsigned)(_c >> 32) : ts_hi; ++nts; } } while (0)
    PG8_STAMP();
    unsigned voffA[2], voffB[2];
#pragma unroll
    for (int i = 0; i < 2; ++i) { int R, C; stage_rc(tid * 16 + i * 8192, R, C); const int Rb = Epi::PERM ? ((R & ~31) + perm32(R & 31)) : R;
        voffA[i] = (unsigned)(R * K + C) * 2u; voffB[i] = (unsigned)(Rb * K + C) * 2u; }
    const size_t kstep = (size_t)(BK * 2);
    const size_t hstep = (size_t)HALF * K * 2;
    const size_t tstep = 2 * hstep;
    const unsigned ldsw = (unsigned)wid * 1024u;
    const int aoff = lds_byte(wr * 64 + fr, fq * 8), boff = lds_byte(wc * 32 + fr, fq * 8);
#define PG8_SA(b, h) (((b) * 2 + (h)) * HTB)
#define PG8_SB(b, h) ((4 + (b) * 2 + (h)) * HTB)
#define PG8_STAGE(bufoff, gbase, voff) do { _Pragma("unroll") for (int _i = 0; _i < 2; ++_i) \
        __builtin_amdgcn_global_load_lds((const unsigned*)((const char*)(gbase) + (voff)[_i]), (PG8_LAS unsigned*)(lds + (bufoff) + ldsw + _i * 8192), 16, 0, 0); } while (0)
#define PG8_LDA(dst, b, h) do { _Pragma("unroll") for (int m = 0; m < 4; ++m) _Pragma("unroll") for (int k = 0; k < 2; ++k) dst[m][k] = *(const PG8_LAS bf16x8*)(lds + PG8_SA(b, h) + aoff + m * 2048 + k * 1024); } while (0)
#define PG8_LDB(dst, b, h) do { _Pragma("unroll") for (int n = 0; n < 2; ++n) _Pragma("unroll") for (int k = 0; k < 2; ++k) dst[n][k] = *(const PG8_LAS bf16x8*)(lds + PG8_SB(b, h) + boff + n * 2048 + k * 1024); } while (0)
#define PG8_MMA(ai, bj, At, Bt) do { __builtin_amdgcn_s_setprio(1); _Pragma("unroll") for (int m = 0; m < 4; ++m) _Pragma("unroll") for (int n = 0; n < 2; ++n) _Pragma("unroll") for (int k = 0; k < 2; ++k) \
        acc[ai][bj][m][n] = __builtin_amdgcn_mfma_f32_16x16x32_bf16(Bt[n][k], At[m][k], acc[ai][bj][m][n], 0, 0, 0); __builtin_amdgcn_s_setprio(0); } while (0)
#define PG8_WAIT_V(n) asm volatile("s_waitcnt vmcnt(" #n ")" ::: "memory")
#define PG8_WAIT_L(n) asm volatile("s_waitcnt lgkmcnt(" #n ")" ::: "memory")
#define PG8_BAR __builtin_amdgcn_s_barrier()
#define PG8_SCHED __builtin_amdgcn_sched_barrier(0)
    Unit cur, nxt; int ui = 0;
    if (!S.next(0, cur)) return;
    f32x4 acc[2][2][4][2];
#pragma unroll
    for (int a = 0; a < 2; ++a)
#pragma unroll
        for (int b = 0; b < 2; ++b)
#pragma unroll
            for (int m = 0; m < 4; ++m)
#pragma unroll
                for (int n = 0; n < 2; ++n) acc[a][b][m][n] = (f32x4){0.f, 0.f, 0.f, 0.f};
    bf16x8 At[4][2], B0[2][2], B1[2][2];
    const char* cA = (const char*)g.A + (size_t)cur.pm * tstep; const char* cB = (const char*)g.Bt + (size_t)cur.pn * tstep;
    S.a_ready(cur);
    PG8_STAGE(PG8_SB(0, 0), cB, voffB); PG8_STAGE(PG8_SA(0, 0), cA, voffA); PG8_STAGE(PG8_SB(0, 1), cB + hstep, voffB); PG8_STAGE(PG8_SA(0, 1), cA + hstep, voffA);
    if (wr == 1) PG8_BAR;
    PG8_WAIT_V(4); PG8_BAR;
    PG8_STAGE(PG8_SB(1, 0), cB + kstep, voffB); PG8_STAGE(PG8_SA(1, 0), cA + kstep, voffA); PG8_STAGE(PG8_SB(1, 1), cB + hstep + kstep, voffB);
    PG8_WAIT_V(6); PG8_BAR;
    PG8_STAMP();
    for (;;) {
        const bool has_next = S.next(ui + 1, nxt);
        const char* nA = has_next ? (const char*)g.A + (size_t)nxt.pm * tstep : cA; const char* nB = has_next ? (const char*)g.Bt + (size_t)nxt.pn * tstep : cB;
        for (int t = 0; t < nt; t += 2) {
            const bool last = (t == nt - 2);
            const char* a1 = cA + (size_t)(t + 1) * kstep;
            const char* a2 = last ? nA : cA + (size_t)(t + 2) * kstep; const char* b2 = last ? nB : cB + (size_t)(t + 2) * kstep;
            const char* a3 = a2 + kstep; const char* b3 = b2 + kstep;
            if (last && has_next) S.a_ready(nxt);
            PG8_LDB(B0, 0, 0); PG8_SCHED; PG8_LDA(At, 0, 0); PG8_STAGE(PG8_SA(1, 1), a1 + hstep, voffA);
            PG8_WAIT_L(8); PG8_BAR; PG8_WAIT_L(0); PG8_MMA(0, 0, At, B0); PG8_BAR; PG8_SCHED;
            PG8_LDB(B1, 0, 1); PG8_STAGE(PG8_SB(0, 0), b2, voffB);
            PG8_BAR; PG8_WAIT_L(0); PG8_MMA(0, 1, At, B1); PG8_BAR;
            PG8_LDA(At, 0, 1); PG8_STAGE(PG8_SA(0, 0), a2, voffA);
            PG8_BAR; PG8_WAIT_L(0); PG8_MMA(1, 0, At, B0); PG8_BAR; PG8_SCHED;
            PG8_STAGE(PG8_SB(0, 1), b2 + hstep, voffB);
            PG8_WAIT_V(6); PG8_BAR; PG8_MMA(1, 1, At, B1); PG8_BAR;
            PG8_LDB(B0, 1, 0); PG8_SCHED; PG8_LDA(At, 1, 0); PG8_STAGE(PG8_SA(0, 1), a2 + hstep, voffA);
            PG8_WAIT_L(8); PG8_BAR; PG8_WAIT_L(0); PG8_MMA(0, 0, At, B0); PG8_BAR; PG8_SCHED;
            PG8_LDB(B1, 1, 1); PG8_STAGE(PG8_SB(1, 0), b3, voffB);
            PG8_BAR; PG8_WAIT_L(0); PG8_MMA(0, 1, At, B1); PG8_BAR;
            PG8_LDA(At, 1, 1); PG8_STAGE(PG8_SA(1, 0), a3, voffA);
            PG8_BAR; PG8_WAIT_L(0); PG8_MMA(1, 0, At, B0); PG8_BAR; PG8_SCHED;
            PG8_STAGE(PG8_SB(1, 1), b3 + hstep, voffB);
            PG8_WAIT_V(6); PG8_BAR; PG8_MMA(1, 1, At, B1); PG8_BAR;
        }
        PG8_STAMP();
        if constexpr (!Epi::AFTER_DRAIN) { E(acc, cur, wr, wc, fr, fq); S.done(cur); }
        PG8_STAMP();
        if (!has_next) break;
#pragma unroll
        for (int a = 0; a < 2; ++a)
#pragma unroll
            for (int b = 0; b < 2; ++b)
#pragma unroll
                for (int m = 0; m < 4; ++m)
#pragma unroll
                    for (int n = 0; n < 2; ++n) acc[a][b][m][n] = (f32x4){0.f, 0.f, 0.f, 0.f};
        cur = nxt; cA = nA; cB = nB; ++ui;
    }
    PG8_WAIT_V(0);
    if (wr == 0) PG8_BAR;
    PG8_BAR;
    if constexpr (Epi::AFTER_DRAIN) { E.fused(acc, cur, wr, wc, fr, fq, lds, wid, lane); S.done(cur); }
    PG8_STAMP();
    if (STAMP && wid == 0) { stamps[lane] = lane < nts ? (((unsigned long long)(unsigned)ts_hi << 32) | (unsigned)ts_lo) : 0ull;
        if (lane == 62) stamps[62] = rt_entry; if (lane == 63) stamps[63] = (unsigned long long)wall_clock64(); }
#undef PG8_STAMP
#undef PG8_SA
#undef PG8_SB
#undef PG8_STAGE
#undef PG8_LDA
#undef PG8_LDB
#undef PG8_MMA
#undef PG8_WAIT_V
#undef PG8_WAIT_L
#undef PG8_BAR
#undef PG8_SCHED
}
}
using pg8::bf16_t; using pg8::bf16x8; using pg8::f32x4; using pg8::u32x4;
typedef float f32x2 __attribute__((ext_vector_type(2)));
typedef __bf16 bf16x2_t __attribute__((ext_vector_type(2)));
__device__ __forceinline__ unsigned cvt_pk_bf16(float lo, float hi) { const bf16x2_t r = __builtin_convertvector((f32x2){lo, hi}, bf16x2_t); return __builtin_bit_cast(unsigned, r); }
typedef unsigned u32x2 __attribute__((ext_vector_type(2)));
typedef short s16x4 __attribute__((ext_vector_type(4)));
#define LAS __attribute__((address_space(3)))
typedef LAS unsigned char* LP;
#define XB_TMO      128
#define XB_XCNT(j)  (256  + 64 * (j))
#define XB_XSUB(j)  (1280 + 64 * (j))
#define XB_XGEN(j)  (2304 + 64 * (j))
#define XB_TOP      3328
#define XB_TOPGEN   3392
#define XCD_BAR_WORDS 3456
#define XB_SPIN_CAP (1u << 18)

__device__ __forceinline__ unsigned xb_ld(unsigned* p)              { return __hip_atomic_load(p, __ATOMIC_RELAXED, __HIP_MEMORY_SCOPE_AGENT); }
__device__ __forceinline__ unsigned xb_add(unsigned* p, unsigned v) { return __hip_atomic_fetch_add(p, v, __ATOMIC_RELAXED, __HIP_MEMORY_SCOPE_AGENT); }
__device__ __forceinline__ unsigned xb_xcc_id() { return (unsigned)__builtin_amdgcn_s_getreg((3 << 11) | 20) & 0xFu; }
#define XB_SPIN(cond, bar) do { unsigned _sp = 0; while (cond) { __builtin_amdgcn_s_sleep(1); \
    if ((++_sp & 255u) == 0u) { if (xb_ld(&(bar)[XB_TMO])) break; if (_sp > XB_SPIN_CAP) { atomicAdd(&(bar)[XB_TMO], 1u); break; } } } } while (0)

struct XcdBarrier {
    unsigned* bar; unsigned x;
    volatile LAS unsigned* st;
};

__device__ __forceinline__ XcdBarrier xcd_barrier_post(unsigned* bar, volatile LAS unsigned* st) {
    XcdBarrier b; b.bar = bar; b.x = xb_xcc_id(); b.st = st;
    if (threadIdx.x == 0) (void)xb_add(&bar[XB_XCNT(b.x)], 1u);
    return b;
}
__device__ __forceinline__ void xcd_barrier_complete(unsigned* bar, unsigned x, unsigned& nloc, unsigned& nx) {
    const unsigned G = gridDim.x * gridDim.y * gridDim.z;
    unsigned sum, cnt, mine, sp = 0u;
    for (;;) {
        sum = 0u; cnt = 0u; mine = 0u;
#pragma unroll
        for (unsigned j = 0; j < 16; ++j) { const unsigned c = xb_ld(&bar[XB_XCNT(j)]); sum += c; cnt += (c > 0u) ? 1u : 0u; mine = (j == x) ? c : mine; }
        if (sum == G) break;
        __builtin_amdgcn_s_sleep(1);
        if ((++sp & 255u) == 0u) { if (xb_ld(&bar[XB_TMO])) break; if (sp > XB_SPIN_CAP) { atomicAdd(&bar[XB_TMO], 1u); break; } }
    }
    nloc = mine > 0u ? mine : 1u; nx = cnt > 0u ? cnt : 1u;
}

__device__ __forceinline__ void xcd_barrier(const XcdBarrier& b) {
    asm volatile("s_waitcnt vmcnt(0)" ::: "memory");
    __syncthreads();
    if (threadIdx.x == 0) {
        unsigned* bar = b.bar;
        __builtin_amdgcn_s_waitcnt(0);
        unsigned nloc = b.st[0], nx = b.st[1];
        if (nloc == 0u) { xcd_barrier_complete(bar, b.x, nloc, nx); b.st[0] = nloc; b.st[1] = nx; }
        const unsigned old = xb_add(&bar[XB_XSUB(b.x)], 1u);
        const unsigned gen = old / nloc;
        if (old + 1u == (gen + 1u) * nloc) {
            __builtin_amdgcn_fence(__ATOMIC_RELEASE, "agent");
            asm volatile("s_waitcnt vmcnt(0)" ::: "memory");
            const unsigned og = xb_add(&bar[XB_TOP], 1u);
            const unsigned tg = og / nx;
            if (og + 1u == (tg + 1u) * nx) xb_add(&bar[XB_TOPGEN], 1u);
            else XB_SPIN(xb_ld(&bar[XB_TOPGEN]) == tg, bar);
            __builtin_amdgcn_fence(__ATOMIC_ACQUIRE, "agent");
            xb_add(&bar[XB_XGEN(b.x)], 1u);
            asm volatile("s_waitcnt vmcnt(0)" ::: "memory");
        } else {
            XB_SPIN(xb_ld(&bar[XB_XGEN(b.x)]) == gen, bar);
            __builtin_amdgcn_fence(__ATOMIC_ACQUIRE, "agent");
            asm volatile("s_waitcnt vmcnt(0)" ::: "memory");
        }
    }
    __syncthreads();
}

constexpr int T_ = 32768, D_ = 1024, DI_ = 2048, SEQ_ = 2048;
constexpr float EPS_ = 1e-6f;
constexpr size_t MiB = 1024 * 1024;
constexpr size_t WS_WINA = 0, WS_WOUTA = 12 * MiB, WS_WINB = 16 * MiB, WS_WOUTB = 32 * MiB, WS_MOD = 36 * MiB, WS_WSM = 36 * MiB + 512 * 1024,
                 WS_VST = 37 * MiB, WS_H = 46 * MiB, WS_P0 = 110 * MiB, WS_P1 = 238 * MiB, WS_P2 = 366 * MiB, WS_END = 494 * MiB;
constexpr int LDS_BAR_OFF = 155648;
constexpr int LDS_BYTES = LDS_BAR_OFF + 16;
constexpr size_t WS_BAR = 45 * MiB;
constexpr int NPHASE = 11;

__device__ __forceinline__ float bf2f(unsigned short b) { return __uint_as_float(((unsigned)b) << 16); }
__device__ __forceinline__ float bflo(unsigned w) { return __uint_as_float(w << 16); }
__device__ __forceinline__ float bfhi(unsigned w) { return __uint_as_float(w & 0xffff0000u); }
__device__ __forceinline__ float fexp(float x) { return __builtin_amdgcn_exp2f(x * 1.4426950408889634f); }
__device__ __forceinline__ float sigm(float x) { return __builtin_amdgcn_rcpf(1.0f + fexp(-x)); }
__device__ __forceinline__ float silu_f(float x) { return x * sigm(x); }
__device__ __forceinline__ float gelu_f(float x) { return x * sigm(1.5957691216057308f * (x + 0.044715f * x * x * x)); }
__device__ __forceinline__ float flog(float x) { return __builtin_amdgcn_logf(x) * 0.6931471805599453f; }
__device__ __forceinline__ bf16x8 mk8(s16x4 a, s16x4 b) { return __builtin_shufflevector(a, b, 0, 1, 2, 3, 4, 5, 6, 7); }
__device__ __forceinline__ s16x4 trrd(LP p) { return __builtin_amdgcn_ds_read_tr16_b64_v4i16((LAS s16x4*)p); }
__device__ __forceinline__ f32x2 ex2_2(f32x2 q) { f32x2 e; e.x = __builtin_amdgcn_exp2f(q.x); e.y = __builtin_amdgcn_exp2f(q.y); return e; }
__device__ __forceinline__ f32x2 rcp_2(f32x2 d) { f32x2 r; r.x = __builtin_amdgcn_rcpf(d.x); r.y = __builtin_amdgcn_rcpf(d.y); return r; }
__device__ __forceinline__ f32x2 sigm2(f32x2 x) { return rcp_2(ex2_2(x * -1.4426950408889634f) + 1.0f); }
__device__ __forceinline__ f32x2 silu2(f32x2 x) { return x * sigm2(x); }
__device__ __forceinline__ f32x2 gelu2(f32x2 x) { const f32x2 t = x * x; const f32x2 p = t * -0.10294323974f + -2.3022081983f; return x * rcp_2(ex2_2(p * x) + 1.0f); }
__device__ __forceinline__ void lds_barrier() { asm volatile("s_waitcnt lgkmcnt(0)" ::: "memory"); __builtin_amdgcn_s_barrier(); asm volatile("" ::: "memory"); }
__device__ __forceinline__ f32x2 gelu_silu2(f32x2 u, f32x2 g) { const f32x2 t = u * u; const f32x2 p = t * -0.10294323974f + -2.3022081983f; const f32x2 eu = ex2_2(p * u) + 1.0f, eg = ex2_2(g * -1.4426950408889634f) + 1.0f; return (u * g) * rcp_2(eu * eg); }
#define MFMA16(a, b, c) __builtin_amdgcn_mfma_f32_16x16x32_bf16((a), (b), (c), 0, 0, 0)

struct EpiV {
    static constexpr bool PERM = true, AFTER_DRAIN = false;
    bf16_t* Vo; f32x2* vst;
    __device__ __forceinline__ void operator()(const f32x4 (&acc)[2][2][4][2], const pg8::Unit& u, int wr, int wc, int fr, int fq) const {
        const int row0 = u.pm * 256 + wr * 64 + fr, col0 = u.pn * 256 + wc * 32 + 8 * fq;
#pragma unroll
        for (int ai = 0; ai < 2; ++ai)
#pragma unroll
            for (int m = 0; m < 4; ++m) {
                const int row = row0 + ai * 128 + m * 16; float s1 = 0.f, s2 = 0.f;
#pragma unroll
                for (int bj = 0; bj < 2; ++bj) {
                    float v[8];
#pragma unroll
                    for (int j = 0; j < 4; j += 2) { const f32x2 r0 = gelu2((f32x2){acc[ai][bj][m][0][j], acc[ai][bj][m][0][j + 1]}), r1 = gelu2((f32x2){acc[ai][bj][m][1][j], acc[ai][bj][m][1][j + 1]});
                        v[j] = r0.x; v[j + 1] = r0.y; v[4 + j] = r1.x; v[4 + j + 1] = r1.y; }
#pragma unroll
                    for (int j = 0; j < 8; ++j) { s1 += v[j]; s2 += v[j] * v[j]; }
                    u32x4 w; w.x = cvt_pk_bf16(v[0], v[1]); w.y = cvt_pk_bf16(v[2], v[3]); w.z = cvt_pk_bf16(v[4], v[5]); w.w = cvt_pk_bf16(v[6], v[7]);
                    *(u32x4*)(Vo + (size_t)row * DI_ + col0 + bj * 128) = w;
                }
                s1 += __shfl_xor(s1, 16); s1 += __shfl_xor(s1, 32); s2 += __shfl_xor(s2, 16); s2 += __shfl_xor(s2, 32);
                if (fq == 0) vst[(size_t)row * 32 + u.pn * 4 + wc] = (f32x2){s1, s2};
            }
    }
};
struct EpiUG {
    static constexpr bool PERM = true, AFTER_DRAIN = false;
    const bf16_t* S; bf16_t* Y;
    __device__ __forceinline__ void operator()(const f32x4 (&acc)[2][2][4][2], const pg8::Unit& u, int wr, int wc, int fr, int fq) const {
        const int row0 = u.pm * 256 + wr * 64 + fr, col0 = u.pn * 128 + wc * 32 + 8 * fq;
        u32x4 svv[2][4];
#pragma unroll
        for (int ai = 0; ai < 2; ++ai)
#pragma unroll
            for (int m = 0; m < 4; ++m) svv[ai][m] = *(const u32x4*)(S + (size_t)(row0 + ai * 128 + m * 16) * DI_ + col0);
#pragma unroll
        for (int ai = 0; ai < 2; ++ai)
#pragma unroll
            for (int m = 0; m < 4; ++m) {
                const size_t off = (size_t)(row0 + ai * 128 + m * 16) * DI_ + col0;
                const u32x4 sv = svv[ai][m];
                float v[8];
#pragma unroll
                for (int n = 0; n < 2; ++n)
#pragma unroll
                    for (int j = 0; j < 4; j += 2) { const f32x2 r = gelu_silu2((f32x2){acc[ai][0][m][n][j], acc[ai][0][m][n][j + 1]}, (f32x2){acc[ai][1][m][n][j], acc[ai][1][m][n][j + 1]}); v[4 * n + j] = r.x; v[4 * n + j + 1] = r.y; }
                u32x4 w;
                w.x = cvt_pk_bf16(v[0] * bflo(sv.x), v[1] * bfhi(sv.x)); w.y = cvt_pk_bf16(v[2] * bflo(sv.y), v[3] * bfhi(sv.y));
                w.z = cvt_pk_bf16(v[4] * bflo(sv.z), v[5] * bfhi(sv.z)); w.w = cvt_pk_bf16(v[6] * bflo(sv.w), v[7] * bfhi(sv.w));
                *(u32x4*)(Y + off) = w;
            }
    }
};
template <bool ADD> struct EpiDelta {
    static constexpr bool PERM = true, AFTER_DRAIN = false;
    const bf16_t* Din; bf16_t* Dout; const float* gate;
    __device__ __forceinline__ void operator()(const f32x4 (&acc)[2][2][4][2], const pg8::Unit& u, int wr, int wc, int fr, int fq) const {
        const int row0 = u.pm * 256 + wr * 64 + fr, col0 = u.pn * 256 + wc * 32 + 8 * fq;
        const int b = (u.pm * 256) >> 11;
        f32x4 gv[2][2];
#pragma unroll
        for (int bj = 0; bj < 2; ++bj)
#pragma unroll
            for (int n = 0; n < 2; ++n) gv[bj][n] = *(const f32x4*)(gate + b * 3072 + col0 + bj * 128 + n * 4);
        u32x4 dv[2][4][2];
        if (ADD) {
#pragma unroll
            for (int ai = 0; ai < 2; ++ai)
#pragma unroll
                for (int m = 0; m < 4; ++m)
#pragma unroll
                    for (int bj = 0; bj < 2; ++bj) dv[ai][m][bj] = *(const u32x4*)(Din + (size_t)(row0 + ai * 128 + m * 16) * D_ + col0 + bj * 128);
        }
#pragma unroll
        for (int ai = 0; ai < 2; ++ai)
#pragma unroll
            for (int m = 0; m < 4; ++m) {
                const size_t off = (size_t)(row0 + ai * 128 + m * 16) * D_ + col0;
#pragma unroll
                for (int bj = 0; bj < 2; ++bj) {
                    f32x4 v0 = gv[bj][0] * acc[ai][bj][m][0], v1 = gv[bj][1] * acc[ai][bj][m][1];
                    if (ADD) { const u32x4 o = dv[ai][m][bj];
                        v0[0] += bflo(o.x); v0[1] += bfhi(o.x); v0[2] += bflo(o.y); v0[3] += bfhi(o.y); v1[0] += bflo(o.z); v1[1] += bfhi(o.z); v1[2] += bflo(o.w); v1[3] += bfhi(o.w); }
                    u32x4 w; w.x = cvt_pk_bf16(v0[0], v0[1]); w.y = cvt_pk_bf16(v0[2], v0[3]); w.z = cvt_pk_bf16(v1[0], v1[1]); w.w = cvt_pk_bf16(v1[2], v1[3]);
                    *(u32x4*)(Dout + off + bj * 128) = w;
                }
            }
    }
};
struct EpiB1 {
    static constexpr bool PERM = true, AFTER_DRAIN = false;
    bf16_t* P0; bf16_t* P1; bf16_t* P2; const float* lbraw;
    template <int KIND> __device__ __forceinline__ void body(const f32x4 (&acc)[2][2][4][2], bf16_t* base, int row0, int col0) const {
        float lb[2][8];
        if (KIND == 1) {
#pragma unroll
            for (int bj = 0; bj < 2; ++bj) {
                const f32x4 a0 = *(const f32x4*)(lbraw + col0 + bj * 128), a1 = *(const f32x4*)(lbraw + col0 + bj * 128 + 4), c0 = *(const f32x4*)(lbraw + DI_ + col0 + bj * 128), c1 = *(const f32x4*)(lbraw + DI_ + col0 + bj * 128 + 4);
#pragma unroll
                for (int j = 0; j < 4; ++j) { lb[bj][j] = sigm(c0[j] - a0[j]); lb[bj][4 + j] = sigm(c1[j] - a1[j]); }
            }
        }
#pragma unroll
        for (int ai = 0; ai < 2; ++ai)
#pragma unroll
            for (int m = 0; m < 4; ++m) {
                const int row = row0 + ai * 128 + m * 16;
#pragma unroll
                for (int bj = 0; bj < 2; ++bj) {
                    float v[8];
#pragma unroll
                    for (int j = 0; j < 4; ++j) { v[j] = acc[ai][bj][m][0][j]; v[4 + j] = acc[ai][bj][m][1][j]; }
                    if (KIND == 0) {
#pragma unroll
                        for (int j = 0; j < 8; j += 2) { const f32x2 r = silu2((f32x2){v[j], v[j + 1]}); v[j] = r.x; v[j + 1] = r.y; }
                    } else if (KIND == 1) {
#pragma unroll
                        for (int j = 0; j < 8; j += 2) { const f32x2 sg = sigm2((f32x2){v[j], v[j + 1]}), l2 = (f32x2){lb[bj][j], lb[bj][j + 1]}; const f32x2 f = (sg - l2 * sg) + l2;
                            v[j] = __builtin_amdgcn_logf(f.x); v[j + 1] = __builtin_amdgcn_logf(f.y); }
                    }
                    u32x4 w; w.x = cvt_pk_bf16(v[0], v[1]); w.y = cvt_pk_bf16(v[2], v[3]); w.z = cvt_pk_bf16(v[4], v[5]); w.w = cvt_pk_bf16(v[6], v[7]);
                    __builtin_nontemporal_store(w, (u32x4*)(base + (size_t)row * DI_ + col0 + bj * 128));
                }
            }
    }
    __device__ __forceinline__ void operator()(const f32x4 (&acc)[2][2][4][2], const pg8::Unit& u, int wr, int wc, int fr, int fq) const {
        const int kind = u.pn >> 3, pt = u.pn & 7;
        bf16_t* base = P0 + (size_t)kind * (size_t)(64 * 1024 * 1024);
        const int row0 = u.pm * 256 + wr * 64 + fr, col0 = pt * 256 + wc * 32 + 8 * fq;
        if (kind == 0) body<0>(acc, base, row0, col0); else if (kind == 1) body<1>(acc, base, row0, col0); else body<2>(acc, base, row0, col0);
    }
};
struct EpiGate {
    static constexpr bool PERM = true, AFTER_DRAIN = false;
    bf16_t* O;
    __device__ __forceinline__ void operator()(const f32x4 (&acc)[2][2][4][2], const pg8::Unit& u, int wr, int wc, int fr, int fq) const {
        const int row0 = u.pm * 256 + wr * 64 + fr, col0 = u.pn * 256 + wc * 32 + 8 * fq;
        u32x4 ov[2][4][2];
#pragma unroll
        for (int ai = 0; ai < 2; ++ai)
#pragma unroll
            for (int m = 0; m < 4; ++m)
#pragma unroll
                for (int bj = 0; bj < 2; ++bj) ov[ai][m][bj] = *(const u32x4*)(O + (size_t)(row0 + ai * 128 + m * 16) * DI_ + col0 + bj * 128);
#pragma unroll
        for (int ai = 0; ai < 2; ++ai)
#pragma unroll
            for (int m = 0; m < 4; ++m) {
                const int row = row0 + ai * 128 + m * 16;
#pragma unroll
                for (int bj = 0; bj < 2; ++bj) {
                    bf16_t* p = O + (size_t)row * DI_ + col0 + bj * 128;
                    const u32x4 o = ov[ai][m][bj];
                    float v[8];
#pragma unroll
                    for (int j = 0; j < 4; j += 2) { const f32x2 r0 = silu2((f32x2){acc[ai][bj][m][0][j], acc[ai][bj][m][0][j + 1]}), r1 = silu2((f32x2){acc[ai][bj][m][1][j], acc[ai][bj][m][1][j + 1]});
                        v[j] = r0.x; v[j + 1] = r0.y; v[4 + j] = r1.x; v[4 + j + 1] = r1.y; }
                    u32x4 w;
                    w.x = cvt_pk_bf16(v[0] * bflo(o.x), v[1] * bfhi(o.x)); w.y = cvt_pk_bf16(v[2] * bflo(o.y), v[3] * bfhi(o.y));
                    w.z = cvt_pk_bf16(v[4] * bflo(o.z), v[5] * bfhi(o.z)); w.w = cvt_pk_bf16(v[6] * bflo(o.w), v[7] * bfhi(o.w));
                    *(u32x4*)p = w;
                }
            }
    }
};

__device__ __forceinline__ void transpose_tile(const float* W, bf16_t* Bt, int K, int N, int k0, int n0, LP L, int dmode) {
    const int tid = threadIdx.x;
    LAS float* S = (LAS float*)L;
    f32x4 ld[8];
#pragma unroll
    for (int i = 0; i < 8; ++i) ld[i] = __builtin_nontemporal_load((const f32x4*)(W + (size_t)(k0 + i * 8 + (tid >> 6)) * N + n0 + (tid & 63) * 4));
#pragma unroll
    for (int i = 0; i < 8; ++i) *(LAS f32x4*)(S + (i * 8 + (tid >> 6)) * 288 + 4 * i + (tid & 63) * 4) = ld[i];
    __syncthreads();
#pragma unroll
    for (int q = 0; q < 4; ++q) {
        const int id = tid + 512 * q, n = id >> 3, kc = (id & 7) * 8;
        int drow = n0 + n;
        if (dmode == 1) { const int kind = n0 >> 11, c0 = n0 & 2047; drow = (kind == 1) ? (c0 + n) : (2048 + 256 * ((c0 >> 7) + (n >> 7)) + (kind == 2 ? 128 : 0) + (n & 127)); }
        float v[8];
#pragma unroll
        for (int j = 0; j < 8; ++j) v[j] = S[(kc + j) * 288 + 4 * (kc >> 3) + n];
        u32x4 w; w.x = cvt_pk_bf16(v[0], v[1]); w.y = cvt_pk_bf16(v[2], v[3]); w.z = cvt_pk_bf16(v[4], v[5]); w.w = cvt_pk_bf16(v[6], v[7]);
        *(u32x4*)(Bt + (size_t)drow * K + k0 + kc) = w;
    }
    __syncthreads();
}
__device__ __forceinline__ void mod_unit(const float* c, const float* w_ada, const float* b_ada, float* mod, int unit, LP L) {
    const int tid = threadIdx.x, layer = unit / 96, cgp = unit % 96;
    LAS float* cact = (LAS float*)L;
    LAS float* red = (LAS float*)(L + 65536);
    for (int i = tid; i < 16 * 1024; i += 512) { const int b = i >> 10, k = i & 1023; cact[k * 16 + b] = silu_f(c[i]); }
    __syncthreads();
    const int col = tid & 31, sl = tid >> 5;
    float acc[16];
#pragma unroll
    for (int b = 0; b < 16; ++b) acc[b] = 0.f;
    const float* wp = w_ada + (size_t)layer * 1024 * 3072 + (size_t)(64 * sl) * 3072 + 32 * cgp + col;
#pragma unroll 8
    for (int kk = 0; kk < 64; ++kk) {
        const float w = __builtin_nontemporal_load(wp + (size_t)kk * 3072);
        const LAS f32x4* ca = (const LAS f32x4*)(cact + (64 * sl + kk) * 16);
#pragma unroll
        for (int q = 0; q < 4; ++q) { const f32x4 cv = ca[q]; acc[4 * q] += w * cv[0]; acc[4 * q + 1] += w * cv[1]; acc[4 * q + 2] += w * cv[2]; acc[4 * q + 3] += w * cv[3]; }
    }
#pragma unroll
    for (int b = 0; b < 16; ++b) red[(sl * 16 + b) * 32 + col] = acc[b];
    __syncthreads();
    { const int b = tid >> 5; float s = 0.f;
#pragma unroll
      for (int q = 0; q < 16; ++q) s += red[(q * 16 + b) * 32 + col];
      mod[(size_t)(layer * 16 + b) * 3072 + 32 * cgp + col] = s + b_ada[layer * 3072 + 32 * cgp + col]; }
    __syncthreads();
}
struct PrepArgs { const float *c, *w_ada, *b_ada, *a_w_in, *a_w_s, *a_w_out, *b_w_in, *b_w_out; unsigned char* ws; };
__device__ __forceinline__ void prep_phase(const PrepArgs& a, LP L) {
    const int NT = 192 + 32 + 1152;
    unsigned* qctr = (unsigned*)(a.ws + WS_BAR);
    LAS int* qslot = (LAS int*)(L + LDS_BAR_OFF - 16);
    for (;;) {
        if (threadIdx.x == 0) *qslot = (int)__hip_atomic_fetch_add(qctr, 1u, __ATOMIC_RELAXED, __HIP_MEMORY_SCOPE_AGENT);
        __syncthreads();
        const int t = *qslot;
        __syncthreads();
        if (t >= NT) break;
        if (t < 192) mod_unit(a.c, a.w_ada, a.b_ada, (float*)(a.ws + WS_MOD), t, L);
        else if (t < 224) {
            const int base = (t - 192) * 4096 + threadIdx.x * 8; bf16_t* dst = (bf16_t*)(a.ws + WS_WSM);
            const int tt = (base >> 7) & 127, s0 = base & 127;
            const f32x4 x0 = *(const f32x4*)(a.a_w_s + base), x1 = *(const f32x4*)(a.a_w_s + base + 4);
            const bool z = (tt < 64) && (s0 >= 64);
            u32x4 w; w.x = cvt_pk_bf16(x0[0], x0[1]); w.y = cvt_pk_bf16(x0[2], x0[3]); w.z = cvt_pk_bf16(x1[0], x1[1]); w.w = cvt_pk_bf16(x1[2], x1[3]);
            if (z) w = (u32x4){0u, 0u, 0u, 0u};
            *(u32x4*)(dst + base) = w;
        } else {
            int q = t - 224; const float* W; bf16_t* Bt; int K, N;
            if (q < 384) { W = a.a_w_in; Bt = (bf16_t*)(a.ws + WS_WINA); K = 1024; N = 6144; }
            else if (q < 512) { q -= 384; W = a.a_w_out; Bt = (bf16_t*)(a.ws + WS_WOUTA); K = 2048; N = 1024; }
            else if (q < 1024) { q -= 512; W = a.b_w_in; Bt = (bf16_t*)(a.ws + WS_WINB); K = 1024; N = 8192; }
            else { q -= 1024; W = a.b_w_out; Bt = (bf16_t*)(a.ws + WS_WOUTB); K = 2048; N = 1024; }
            const int ntn = N / 256; transpose_tile(W, Bt, K, N, (q / ntn) * 64, (q % ntn) * 256, L, (W == a.a_w_in) ? 1 : 0);
        }
    }
}

constexpr int NR = 4;
template <bool HAS_D> __device__ __forceinline__ void hnorm_phase(const float* x, const bf16_t* dlt, const float* gain, const float* modl, bf16_t* H) {
    const int lane = threadIdx.x & 63, wave = threadIdx.x >> 6;
    for (int pr = blockIdx.x * 8 + wave; pr < T_ / NR; pr += gridDim.x * 8) {
        const int row = NR * pr, b = row >> 11;
        f32x4 v[NR][4]; u32x2 dv[NR][4]; f32x4 g4[4], sh[4], sc[4];
#pragma unroll
        for (int r = 0; r < NR; ++r)
#pragma unroll
            for (int i = 0; i < 4; ++i) { v[r][i] = __builtin_nontemporal_load((const f32x4*)(x + (size_t)(row + r) * D_ + i * 256 + lane * 4)); if (HAS_D) dv[r][i] = *(const u32x2*)(dlt + (size_t)(row + r) * D_ + i * 256 + lane * 4); }
#pragma unroll
        for (int i = 0; i < 4; ++i) { const int col = i * 256 + lane * 4; g4[i] = *(const f32x4*)(gain + col); sh[i] = *(const f32x4*)(modl + b * 3072 + col); sc[i] = *(const f32x4*)(modl + b * 3072 + 1024 + col); }
        float ss[NR];
#pragma unroll
        for (int r = 0; r < NR; ++r) ss[r] = 0.f;
#pragma unroll
        for (int r = 0; r < NR; ++r)
#pragma unroll
            for (int i = 0; i < 4; ++i) {
                if (HAS_D) { v[r][i][0] += bflo(dv[r][i].x); v[r][i][1] += bfhi(dv[r][i].x); v[r][i][2] += bflo(dv[r][i].y); v[r][i][3] += bfhi(dv[r][i].y); }
                ss[r] += v[r][i][0] * v[r][i][0] + v[r][i][1] * v[r][i][1] + v[r][i][2] * v[r][i][2] + v[r][i][3] * v[r][i][3];
            }
#pragma unroll
        for (int o = 32; o >= 1; o >>= 1) {
#pragma unroll
            for (int r = 0; r < NR; ++r) ss[r] += __shfl_xor(ss[r], o); }
#pragma unroll
        for (int r = 0; r < NR; ++r) {
            const float rstd = __builtin_amdgcn_rsqf(ss[r] * (1.0f / 1024.0f) + EPS_);
#pragma unroll
            for (int i = 0; i < 4; ++i) {
                const f32x4 h = v[r][i] * rstd * g4[i] * (sc[i] + 1.0f) + sh[i];
                u32x2 w; w.x = cvt_pk_bf16(h[0], h[1]); w.y = cvt_pk_bf16(h[2], h[3]);
                *(u32x2*)(H + (size_t)(row + r) * D_ + i * 256 + lane * 4) = w;
            }
        }
    }
}
__device__ __forceinline__ void final_norm_phase(const float* x, const bf16_t* dlt, float* xo, const float* gain) {
    const int lane = threadIdx.x & 63, wave = threadIdx.x >> 6;
    f32x4 g4[4];
#pragma unroll
    for (int i = 0; i < 4; ++i) g4[i] = *(const f32x4*)(gain + i * 256 + lane * 4);
    for (int pr = blockIdx.x * 8 + wave; pr < T_ / NR; pr += gridDim.x * 8) {
        const int row = NR * pr;
        f32x4 v[NR][4]; u32x2 dv[NR][4];
#pragma unroll
        for (int r = 0; r < NR; ++r)
#pragma unroll
            for (int i = 0; i < 4; ++i) { v[r][i] = __builtin_nontemporal_load((const f32x4*)(x + (size_t)(row + r) * D_ + i * 256 + lane * 4)); dv[r][i] = *(const u32x2*)(dlt + (size_t)(row + r) * D_ + i * 256 + lane * 4); }
        float ss[NR];
#pragma unroll
        for (int r = 0; r < NR; ++r) ss[r] = 0.f;
#pragma unroll
        for (int r = 0; r < NR; ++r)
#pragma unroll
            for (int i = 0; i < 4; ++i) {
                v[r][i][0] += bflo(dv[r][i].x); v[r][i][1] += bfhi(dv[r][i].x); v[r][i][2] += bflo(dv[r][i].y); v[r][i][3] += bfhi(dv[r][i].y);
                ss[r] += v[r][i][0] * v[r][i][0] + v[r][i][1] * v[r][i][1] + v[r][i][2] * v[r][i][2] + v[r][i][3] * v[r][i][3];
            }
#pragma unroll
        for (int o = 32; o >= 1; o >>= 1) {
#pragma unroll
            for (int r = 0; r < NR; ++r) ss[r] += __shfl_xor(ss[r], o); }
#pragma unroll
        for (int r = 0; r < NR; ++r) {
            const float rstd = __builtin_amdgcn_rsqf(ss[r] * (1.0f / 1024.0f) + EPS_);
#pragma unroll
            for (int i = 0; i < 4; ++i) __builtin_nontemporal_store(v[r][i] * rstd * g4[i], (f32x4*)(xo + (size_t)(row + r) * D_ + i * 256 + lane * 4));
        }
    }
}

constexpr int SP_WS = 0, SP_WS_RS = 272, SP_ST = 128 * 272, SP_VN = SP_ST + 8 * 128 * 8, SP_VN_RS = 80, SP_VN_W = 128 * 80, SP_BS = SP_VN + 8 * SP_VN_W, SP_END = SP_BS + 512;
static_assert(SP_END <= LDS_BAR_OFF, "spatial lds");
__device__ __forceinline__ void sp_loadv(const bf16_t* V, int nb, int g, int w, int lane, u32x4 (&vr)[8]) {
#pragma unroll
    for (int i = 0; i < 8; ++i) vr[i] = *(const u32x4*)(V + (size_t)(nb * 128 + (lane >> 2) + 16 * i) * DI_ + g * 256 + 32 * w + 8 * (lane & 3));
}
template <int SMODE> __device__ __forceinline__ void spatial_phase(LP L, const bf16_t* U, bf16_t* Y, const bf16_t* V, const bf16_t* G, const f32x2* vst, const bf16_t* wsm, const float* b_s, const float* ln_gain, const float* ln_bias) {
    const int tid = threadIdx.x, lane = tid & 63, w = tid >> 6, fr = lane & 15, fq = lane >> 4, tq = fr >> 2, tp = fr & 3;
    const int vG = (int)gridDim.x & ~7;
    if ((int)blockIdx.x >= vG) return;
    const int g = blockIdx.x & 7, nb0 = blockIdx.x >> 3, nbs = vG >> 3;
    const int nU = (256 - nb0 + nbs - 1) / nbs;
#pragma unroll
    for (int i = 0; i < 4; ++i) { const int id = tid + 512 * i, r = id >> 4, c = id & 15; *(LAS u32x4*)(L + SP_WS + r * SP_WS_RS + c * 16) = *(const u32x4*)(wsm + (size_t)(g * 128 + r) * 128 + c * 8); }
    if (tid < 128) *(LAS float*)(L + SP_BS + tid * 4) = b_s[g * 128 + tid];
    const int dch = g * 256 + 32 * w + 8 * (lane & 3);
    const f32x4 g0 = *(const f32x4*)(ln_gain + dch), g1 = *(const f32x4*)(ln_gain + dch + 4), b0 = *(const f32x4*)(ln_bias + dch), b1 = *(const f32x4*)(ln_bias + dch + 4);
    LP VN = L + SP_VN + w * SP_VN_W;
    for (int i0 = 0; i0 < nU; i0 += 8) {
        const int nbat = (nU - i0) < 8 ? (nU - i0) : 8;
        __syncthreads();
        for (int rr = tid >> 2; rr < nbat * 128; rr += 128) {
            const int iu = rr >> 7, s = rr & 127, nb = nb0 + nbs * (i0 + iu);
            const f32x4* p = (const f32x4*)(vst + (size_t)(nb * 128 + s) * 32 + 8 * (tid & 3));
            float s1 = 0.f, s2 = 0.f;
#pragma unroll
            for (int q = 0; q < 4; ++q) { const f32x4 t = p[q]; s1 += t[0] + t[2]; s2 += t[1] + t[3]; }
            s1 += __shfl_xor(s1, 1); s1 += __shfl_xor(s1, 2); s2 += __shfl_xor(s2, 1); s2 += __shfl_xor(s2, 2);
            const float mu = s1 * (1.0f / 2048.0f), var = s2 * (1.0f / 2048.0f) - mu * mu;
            if ((tid & 3) == 0) *(LAS f32x2*)(L + SP_ST + rr * 8) = (f32x2){mu, __builtin_amdgcn_rsqf(var + EPS_)};
        }
        __syncthreads();
        u32x4 vr[8];
        sp_loadv(V, nb0 + nbs * i0, g, w, lane, vr);
        for (int iu = 0; iu < nbat; ++iu) {
            const int nb = nb0 + nbs * (i0 + iu);
#pragma unroll
            for (int i = 0; i < 8; ++i) {
                const int s = (lane >> 2) + 16 * i; const u32x4 raw = vr[i];
                const f32x2 ms = *(const LAS f32x2*)(L + SP_ST + (iu * 128 + s) * 8);
                float v[8] = {bflo(raw.x), bfhi(raw.x), bflo(raw.y), bfhi(raw.y), bflo(raw.z), bfhi(raw.z), bflo(raw.w), bfhi(raw.w)};
#pragma unroll
                for (int j = 0; j < 4; ++j) { v[j] = (v[j] - ms.x) * ms.y * g0[j] + b0[j]; v[4 + j] = (v[4 + j] - ms.x) * ms.y * g1[j] + b1[j]; }
                u32x4 o; o.x = cvt_pk_bf16(v[0], v[1]); o.y = cvt_pk_bf16(v[2], v[3]); o.z = cvt_pk_bf16(v[4], v[5]); o.w = cvt_pk_bf16(v[6], v[7]);
                *(LAS u32x2*)(VN + s * SP_VN_RS + 8 * (lane & 3)) = (u32x2){o.x, o.y};
                *(LAS u32x2*)(VN + s * SP_VN_RS + 32 + 8 * (lane & 3)) = (u32x2){o.z, o.w};
            }
            if (iu + 1 < nbat) sp_loadv(V, nb + nbs, g, w, lane, vr);
            f32x4 acc[2][8];
#pragma unroll
            for (int dt = 0; dt < 2; ++dt)
#pragma unroll
                for (int tt = 0; tt < 8; ++tt) acc[dt][tt] = (f32x4){0.f, 0.f, 0.f, 0.f};
            bf16x8 af[2][4];
#pragma unroll
            for (int dt = 0; dt < 2; ++dt)
#pragma unroll
                for (int ks = 0; ks < 4; ++ks) { LP p = VN + (32 * ks + 8 * fq + tq) * SP_VN_RS + 32 * dt + 8 * tp; af[dt][ks] = mk8(trrd(p), trrd(p + 4 * SP_VN_RS)); }
#pragma unroll
            for (int tt = 0; tt < 8; ++tt) {
#pragma unroll
                for (int ks = 0; ks < 4; ++ks) {
                    if (tt < 4 && ks >= 2) continue;
                    const bf16x8 bfr = *(const LAS bf16x8*)(L + SP_WS + (16 * tt + fr) * SP_WS_RS + (32 * ks + 8 * fq) * 2);
                    acc[0][tt] = MFMA16(af[0][ks], bfr, acc[0][tt]); acc[1][tt] = MFMA16(af[1][ks], bfr, acc[1][tt]);
                }
            }
#pragma unroll
            for (int tt = 0; tt < 8; ++tt) {
                const int t = 16 * tt + fr; const float bs = *(const LAS float*)(L + SP_BS + t * 4);
                const size_t off = (size_t)(nb * 128 + t) * DI_ + g * 256 + 32 * w + 8 * fq;
                const f32x4 a0 = acc[0][tt], a1 = acc[1][tt];
                u32x4 o; o.x = cvt_pk_bf16(a0[0] + bs, a0[1] + bs); o.y = cvt_pk_bf16(a0[2] + bs, a0[3] + bs); o.z = cvt_pk_bf16(a1[0] + bs, a1[1] + bs); o.w = cvt_pk_bf16(a1[2] + bs, a1[3] + bs);
                *(u32x4*)(Y + off) = o;
            }
        }
    }
}

constexpr int HG_QIN = 0, HG_QIN_RS = 272, HG_KIN = 64 * 272, HG_KIN_RS = 288, HG_IS = HG_KIN + 64 * 288, HG_IS_RS = 288, HG_IS_SZ = 64 * 288, HG_P = HG_IS + 2 * HG_IS_SZ, HG_P_RS = 144,
              HG_ST = HG_P + 64 * 144, HG_ST_RS = 272, HG_AB = HG_ST + 128 * 272, HG_TOT = HG_AB + 64 * 512, HG_ER = HG_TOT + 2048, HG_DEC = HG_ER + 512, HG_E2 = HG_DEC + 512, HG_SSQ = HG_E2 + 512, HG_GN = HG_SSQ + 512, HG_END = HG_GN + 512;
static_assert(HG_END <= LDS_BAR_OFF, "hgrn lds");
struct HgCtx { LP L; const bf16_t* Q; bf16_t* O; const bf16_t* LF; const bf16_t* I; const float* gn_gain; size_t ubase; };
__device__ __forceinline__ void hg_load_f(const HgCtx& x, int c, u32x4 (&lr)[2]) {
    const int tid = threadIdx.x;
#pragma unroll
    for (int i = 0; i < 2; ++i) { const int id = tid + 512 * i, r = id >> 4, cp = id & 15; lr[i] = __builtin_nontemporal_load((const u32x4*)(x.LF + x.ubase + (size_t)(64 * c + r) * DI_ + cp * 8)); }
}
__device__ __forceinline__ void hg_load_q(const HgCtx& x, int c, u32x4 (&qr)[2]) {
    const int tid = threadIdx.x;
#pragma unroll
    for (int i = 0; i < 2; ++i) { const int id = tid + 512 * i, r = id >> 4, cp = id & 15; qr[i] = __builtin_nontemporal_load((const u32x4*)(x.Q + x.ubase + (size_t)(64 * c + r) * DI_ + cp * 8)); }
}
__device__ __forceinline__ void hg_load_i(const HgCtx& x, int c, u32x4 (&ir)[2]) {
    const int tid = threadIdx.x;
#pragma unroll
    for (int i = 0; i < 2; ++i) { const int id = tid + 512 * i, r = id >> 4, cp = id & 15; ir[i] = __builtin_nontemporal_load((const u32x4*)(x.I + x.ubase + (size_t)(64 * c + r) * DI_ + cp * 8)); }
}
__device__ __forceinline__ void hg_s0(const HgCtx& x, int buf, const u32x4 (&lr)[2], const u32x4 (&ir)[2]) {
    LP L = x.L; const int tid = threadIdx.x;
#pragma unroll
    for (int i = 0; i < 2; ++i) {
        const int id = tid + 512 * i, r = id >> 4, cp = id & 15;
        const u32x4 lf = lr[i];
        *(LAS f32x4*)(L + HG_AB + r * 512 + cp * 32) = (f32x4){bflo(lf.x), bfhi(lf.x), bflo(lf.y), bfhi(lf.y)};
        *(LAS f32x4*)(L + HG_AB + r * 512 + cp * 32 + 16) = (f32x4){bflo(lf.z), bfhi(lf.z), bflo(lf.w), bfhi(lf.w)};
        *(LAS u32x4*)(L + HG_IS + buf * HG_IS_SZ + r * HG_IS_RS + cp * 16) = ir[i];
    }
}
__device__ __forceinline__ void hg_s1(const HgCtx& x) {
    LP L = x.L; const int tid = threadIdx.x, k = tid & 127, seg = tid >> 7;
    float run = 0.f;
#pragma unroll
    for (int h8 = 0; h8 < 2; ++h8) {
        float a[8];
#pragma unroll
        for (int j = 0; j < 8; ++j) a[j] = *(const LAS float*)(L + HG_AB + (16 * seg + 8 * h8 + j) * 512 + k * 4);
#pragma unroll
        for (int j = 0; j < 8; ++j) { run += a[j]; *(LAS float*)(L + HG_AB + (16 * seg + 8 * h8 + j) * 512 + k * 4) = run; }
        __builtin_amdgcn_sched_barrier(0);
    }
    *(LAS float*)(L + HG_TOT + (seg * 128 + k) * 4) = run;
}
__device__ __forceinline__ void hg_s2(const HgCtx& x, const u32x4 (&qr)[2], const u32x4 (&lr)[2]) {
    LP L = x.L; const int tid = threadIdx.x;
#pragma unroll
    for (int i = 0; i < 2; ++i) {
        const int id = tid + 512 * i, r = id >> 4, cp = id & 15, sg = r >> 4;
        const float m0 = sg > 0 ? 0.f : -1.f, m1 = sg > 1 ? 0.f : -1.f, m2 = sg > 2 ? 1.f : 0.f;
        const u32x4 lf = lr[i], qq = qr[i];
        const unsigned lw[4] = {lf.x, lf.y, lf.z, lf.w}, qw[4] = {qq.x, qq.y, qq.z, qq.w};
        unsigned oq[4], ok[4];
#pragma unroll
        for (int pq = 0; pq < 4; ++pq) {
            const f32x2 av = *(const LAS f32x2*)(L + HG_AB + r * 512 + cp * 32 + 8 * pq);
            const f32x2 t0 = *(const LAS f32x2*)(L + HG_TOT + (8 * cp + 2 * pq) * 4), t1 = *(const LAS f32x2*)(L + HG_TOT + (128 + 8 * cp + 2 * pq) * 4), t2 = *(const LAS f32x2*)(L + HG_TOT + (256 + 8 * cp + 2 * pq) * 4);
            const f32x2 d = av + t0 * m0 + t1 * m1 + t2 * m2;
            const unsigned lww = lw[pq], qww = qw[pq];
            const f32x2 lfv = (f32x2){bflo(lww), bfhi(lww)}, qv = (f32x2){bflo(qww), bfhi(qww)};
            const f32x2 e1 = ex2_2(d), e2 = ex2_2(-d), ef = ex2_2(lfv);
            const f32x2 qi = qv * e1, ki = (1.0f - ef) * e2;
            oq[pq] = cvt_pk_bf16(qi.x, qi.y); ok[pq] = cvt_pk_bf16(ki.x, ki.y);
        }
        *(LAS u32x4*)(L + HG_QIN + r * HG_QIN_RS + cp * 16) = (u32x4){oq[0], oq[1], oq[2], oq[3]};
        *(LAS u32x4*)(L + HG_KIN + r * HG_KIN_RS + cp * 16) = (u32x4){ok[0], ok[1], ok[2], ok[3]};
        __builtin_amdgcn_sched_barrier(0);
    }
    if (tid < 128) {
        const float t0 = *(const LAS float*)(L + HG_TOT + tid * 4), t1 = *(const LAS float*)(L + HG_TOT + (128 + tid) * 4), t2 = *(const LAS float*)(L + HG_TOT + (256 + tid) * 4), t3 = *(const LAS float*)(L + HG_TOT + (384 + tid) * 4);
        const float aref = t0 + t1, alast = aref + t2 + t3;
        *(LAS float*)(L + HG_ER + tid * 4) = __builtin_amdgcn_exp2f(aref); *(LAS float*)(L + HG_DEC + tid * 4) = __builtin_amdgcn_exp2f(alast); *(LAS float*)(L + HG_E2 + tid * 4) = __builtin_amdgcn_exp2f(alast - aref);
    }
}
__device__ __forceinline__ void hg_s3(const HgCtx& x, const f32x4 (&st)[8]) {
    LP L = x.L; const int tid = threadIdx.x, lane = tid & 63, w = tid >> 6, fr = lane & 15, fq = lane >> 4;
    const int ti = w >> 1;
    bf16x8 qb[4];
#pragma unroll
    for (int ks = 0; ks < 4; ++ks) qb[ks] = *(const LAS bf16x8*)(L + HG_QIN + (16 * ti + fr) * HG_QIN_RS + (32 * ks + 8 * fq) * 2);
#pragma unroll
    for (int e2 = 0; e2 < 2; ++e2) {
        const int sj = 2 * (w & 1) + e2;
        f32x4 sc = (f32x4){0.f, 0.f, 0.f, 0.f};
        if (sj <= ti) {
#pragma unroll
            for (int ks = 0; ks < 4; ++ks) { const bf16x8 ka = *(const LAS bf16x8*)(L + HG_KIN + (16 * sj + fr) * HG_KIN_RS + (32 * ks + 8 * fq) * 2); sc = MFMA16(ka, qb[ks], sc); }
        }
        const int t = 16 * ti + fr, s0 = 16 * sj + 4 * fq;
        u32x2 o; o.x = cvt_pk_bf16(s0 <= t ? sc[0] : 0.f, s0 + 1 <= t ? sc[1] : 0.f); o.y = cvt_pk_bf16(s0 + 2 <= t ? sc[2] : 0.f, s0 + 3 <= t ? sc[3] : 0.f);
        *(LAS u32x2*)(L + HG_P + t * HG_P_RS + s0 * 2) = o;
    }
    const f32x4 er = *(const LAS f32x4*)(L + HG_ER + (16 * w + 4 * fq) * 4);
#pragma unroll
    for (int vt = 0; vt < 8; ++vt) {
        const f32x4 sv = st[vt] * er; u32x2 o; o.x = cvt_pk_bf16(sv[0], sv[1]); o.y = cvt_pk_bf16(sv[2], sv[3]);
        *(LAS u32x2*)(L + HG_ST + (16 * vt + fr) * HG_ST_RS + (16 * w + 4 * fq) * 2) = o;
    }
}
__device__ __forceinline__ void hg_s45(const HgCtx& x, int buf, f32x4 (&st)[8], f32x4 (&oacc)[4]) {
    LP L = x.L; const int tid = threadIdx.x, lane = tid & 63, w = tid >> 6, fr = lane & 15, fq = lane >> 4, tq = fr >> 2, tp = fr & 3;
    const int tt = w & 3, vh = w >> 2;
    LP IS = L + HG_IS + buf * HG_IS_SZ;
    {
#pragma unroll
        for (int vt = 0; vt < 4; ++vt) oacc[vt] = (f32x4){0.f, 0.f, 0.f, 0.f};
#pragma unroll
        for (int ks = 0; ks < 2; ++ks) {
            if (ks == 1 && tt < 2) continue;
            const bf16x8 pb = *(const LAS bf16x8*)(L + HG_P + (16 * tt + fr) * HG_P_RS + (32 * ks + 8 * fq) * 2);
#pragma unroll
            for (int vp = 0; vp < 4; vp += 2) {
                LP p0 = IS + (32 * ks + 8 * fq + tq) * HG_IS_RS + (16 * (4 * vh + vp)) * 2 + 8 * tp;
                const bf16x8 i0 = mk8(trrd(p0), trrd(p0 + 4 * HG_IS_RS)), i1 = mk8(trrd(p0 + 32), trrd(p0 + 32 + 4 * HG_IS_RS));
                oacc[vp] = MFMA16(i0, pb, oacc[vp]); oacc[vp + 1] = MFMA16(i1, pb, oacc[vp + 1]);
            }
        }
#pragma unroll
        for (int ks = 0; ks < 4; ++ks) {
            const bf16x8 qb = *(const LAS bf16x8*)(L + HG_QIN + (16 * tt + fr) * HG_QIN_RS + (32 * ks + 8 * fq) * 2);
#pragma unroll
            for (int vp = 0; vp < 4; vp += 2) {
                const bf16x8 s0 = *(const LAS bf16x8*)(L + HG_ST + (16 * (4 * vh + vp) + fr) * HG_ST_RS + (32 * ks + 8 * fq) * 2), s1 = *(const LAS bf16x8*)(L + HG_ST + (16 * (4 * vh + vp + 1) + fr) * HG_ST_RS + (32 * ks + 8 * fq) * 2);
                oacc[vp] = MFMA16(s0, qb, oacc[vp]); oacc[vp + 1] = MFMA16(s1, qb, oacc[vp + 1]);
            }
        }
        float ss = 0.f;
#pragma unroll
        for (int vt = 0; vt < 4; ++vt) ss += oacc[vt][0] * oacc[vt][0] + oacc[vt][1] * oacc[vt][1] + oacc[vt][2] * oacc[vt][2] + oacc[vt][3] * oacc[vt][3];
        ss += __shfl_xor(ss, 16); ss += __shfl_xor(ss, 32);
        if (fq == 0) *(LAS float*)(L + HG_SSQ + (vh * 64 + 16 * tt + fr) * 4) = ss;
    }
    __builtin_amdgcn_sched_barrier(0);
    {
        bf16x8 ka[2];
#pragma unroll
        for (int ks = 0; ks < 2; ++ks) { LP p = L + HG_KIN + (32 * ks + 8 * fq + tq) * HG_KIN_RS + (16 * w) * 2 + 8 * tp; ka[ks] = mk8(trrd(p), trrd(p + 4 * HG_KIN_RS)); }
        const f32x4 dc = *(const LAS f32x4*)(L + HG_DEC + (16 * w + 4 * fq) * 4), e2v = *(const LAS f32x4*)(L + HG_E2 + (16 * w + 4 * fq) * 4);
#pragma unroll
        for (int hv = 0; hv < 4; ++hv) {
            f32x4 tacc[2];
#pragma unroll
            for (int j = 0; j < 2; ++j) tacc[j] = (f32x4){0.f, 0.f, 0.f, 0.f};
#pragma unroll
            for (int ks = 0; ks < 2; ++ks) {
                bf16x8 ib[2];
#pragma unroll
                for (int j = 0; j < 2; ++j) { LP p = IS + (32 * ks + 8 * fq + tq) * HG_IS_RS + (16 * (2 * hv + j)) * 2 + 8 * tp; ib[j] = mk8(trrd(p), trrd(p + 4 * HG_IS_RS)); }
#pragma unroll
                for (int j = 0; j < 2; ++j) tacc[j] = MFMA16(ka[ks], ib[j], tacc[j]);
            }
#pragma unroll
            for (int j = 0; j < 2; ++j) st[2 * hv + j] = dc * st[2 * hv + j] + e2v * tacc[j];
        }
    }
}
__device__ __forceinline__ void hg_s6(const HgCtx& x, int c, const f32x4 (&oacc)[4]) {
    LP L = x.L; const int tid = threadIdx.x, lane = tid & 63, w = tid >> 6, fr = lane & 15, fq = lane >> 4;
    const int tt = w & 3, vh = w >> 2, t = 16 * tt + fr;
    const size_t cbase = x.ubase + (size_t)(64 * c) * DI_;
    const float tot = *(const LAS float*)(L + HG_SSQ + t * 4) + *(const LAS float*)(L + HG_SSQ + (64 + t) * 4);
    const float rstd = __builtin_amdgcn_rsqf(tot * (1.0f / 128.0f) + EPS_);
#pragma unroll
    for (int vt = 0; vt < 4; ++vt) {
        const int v0 = 64 * vh + 16 * vt + 4 * fq; const f32x4 gn = *(const LAS f32x4*)(L + HG_GN + v0 * 4); const f32x4 y = oacc[vt] * rstd * gn;
        u32x2 o; o.x = cvt_pk_bf16(y[0], y[1]); o.y = cvt_pk_bf16(y[2], y[3]);
        *(u32x2*)(x.O + cbase + (size_t)t * DI_ + v0) = o;
    }
}
__device__ __forceinline__ void hg_trip(const HgCtx& x, int c, u32x4 (&qn)[2], u32x4 (&ln)[2], u32x4 (&in)[2], f32x4 (&st)[8]) {
    const bool more = (c + 1 < 32);
    f32x4 oacc[4];
    if (more) { hg_s0(x, (c + 1) & 1, ln, in); if (c + 2 < 32) hg_load_i(x, c + 2, in); }
    __builtin_amdgcn_sched_barrier(0);
    hg_s3(x, st);
    lds_barrier();
    if (more) hg_s1(x);
    __builtin_amdgcn_sched_barrier(0);
    hg_s45(x, c & 1, st, oacc);
    lds_barrier();
    hg_s6(x, c, oacc);
    __builtin_amdgcn_sched_barrier(0);
    if (more) { hg_s2(x, qn, ln); if (c + 2 < 32) hg_load_q(x, c + 2, qn); if (c + 3 < 32) hg_load_f(x, c + 3, ln); }
    lds_barrier();
}
__device__ __forceinline__ void hgrn_phase(LP L, const bf16_t* Q, bf16_t* O, const bf16_t* LF, const bf16_t* I, const float* gn_gain) {
    if (threadIdx.x < 128) *(LAS float*)(L + HG_GN + threadIdx.x * 4) = gn_gain[threadIdx.x];
    __syncthreads();
    for (int unit = blockIdx.x; unit < 256; unit += gridDim.x) {
        const int b = unit >> 4, h = unit & 15;
        HgCtx x{L, Q, O, LF, I, gn_gain, (size_t)b * SEQ_ * DI_ + h * 128};
        f32x4 st[8];
#pragma unroll
        for (int i = 0; i < 8; ++i) st[i] = (f32x4){0.f, 0.f, 0.f, 0.f};
        u32x4 qq[2], la[2], lb[2], ii[2];
        hg_load_f(x, 0, la); hg_load_i(x, 0, ii); hg_load_q(x, 0, qq); hg_load_f(x, 1, lb);
        hg_s0(x, 0, la, ii); hg_load_i(x, 1, ii); lds_barrier(); hg_s1(x); lds_barrier(); hg_s2(x, qq, la); hg_load_q(x, 1, qq); hg_load_f(x, 2, la); lds_barrier();
        for (int c = 0; c < 32; c += 2) { hg_trip(x, c, qq, lb, ii, st); hg_trip(x, c + 1, qq, la, ii, st); }
    }
}

struct Params { const float* in[16]; float* out; unsigned char* ws; int ph_lo, ph_hi; };
__global__ void __launch_bounds__(512) mega_fwd(Params p) {
    extern __shared__ __attribute__((aligned(16))) unsigned char lds_raw[];
    LP L = (LP)lds_raw;
    cg::grid_group grid = cg::this_grid();
    unsigned char* ws = p.ws;
    const float* x = p.in[0];
    float* mod = (float*)(ws + WS_MOD);
    bf16_t* H = (bf16_t*)(ws + WS_H); bf16_t* P0 = (bf16_t*)(ws + WS_P0); bf16_t* P1 = (bf16_t*)(ws + WS_P1); bf16_t* P2 = (bf16_t*)(ws + WS_P2);
    const int G = gridDim.x, bx = blockIdx.x;
    bf16_t* D0 = (bf16_t*)p.out;
    volatile LAS unsigned* bst = (volatile LAS unsigned*)(L + LDS_BAR_OFF);
    if (threadIdx.x < 4) bst[threadIdx.x] = 0u;
    __syncthreads();
    XcdBarrier bar = xcd_barrier_post((unsigned*)(ws + WS_BAR), bst);
    if (p.ph_hi - p.ph_lo > 1) grid.sync();
    const int lo = p.ph_lo, hi = p.ph_hi;
#define IN(k) (lo <= (k) && (k) < hi)
#define SEAM(k) do { if (lo <= (k) && (k) + 1 < hi) xcd_barrier(bar); } while (0)
    if (IN(0)) { PrepArgs a{p.in[1], p.in[3], p.in[4], p.in[5], p.in[8], p.in[10], p.in[11], p.in[14], ws}; prep_phase(a, L); }
    SEAM(0);
    if (IN(1)) hnorm_phase<false>(x, nullptr, p.in[2], mod, H);
    SEAM(1);
    if (IN(2)) { pg8::Gemm g{H, (const bf16_t*)(ws + WS_WINA), T_, 2048, 1024}; pg8::StaticOrder S; S.init(T_, 2048, G, bx); EpiV E{P1, (f32x2*)(ws + WS_VST)};
                 pg8::gemm_phase<EpiV, pg8::StaticOrder>(L, g, S, E, nullptr); }
    SEAM(2);
    if (IN(3)) spatial_phase<1>(L, P1, P1, P1, P1, (const f32x2*)(ws + WS_VST), (const bf16_t*)(ws + WS_WSM), p.in[9], p.in[6], p.in[7]);
    if (IN(3)) { xcd_barrier(bar);
                 pg8::Gemm g{H, (const bf16_t*)(ws + WS_WINA) + (size_t)2048 * 1024, T_, 4096, 1024}; pg8::StaticOrder S; S.init(T_, 4096, G, bx); EpiUG E{P1, P0};
                 pg8::gemm_phase<EpiUG, pg8::StaticOrder>(L, g, S, E, nullptr); }
    SEAM(3);
    if (IN(4)) { pg8::Gemm g{P0, (const bf16_t*)(ws + WS_WOUTA), T_, 1024, 2048}; pg8::StaticOrder S; S.init(T_, 1024, G, bx); EpiDelta<false> E{nullptr, D0, mod + 2048};
                 pg8::gemm_phase<EpiDelta<false>, pg8::StaticOrder>(L, g, S, E, nullptr); }
    SEAM(4);
    if (IN(5)) hnorm_phase<true>(x, D0, p.in[2] + 1024, mod + 16 * 3072, H);
    SEAM(5);
    if (IN(6)) { pg8::Gemm g{H, (const bf16_t*)(ws + WS_WINB), T_, 6144, 1024}; pg8::StaticOrder S; S.init(T_, 6144, G, bx); EpiB1 E{P0, P1, P2, p.in[12]};
                 pg8::gemm_phase<EpiB1, pg8::StaticOrder>(L, g, S, E, nullptr); }
    SEAM(6);
    if (IN(7)) hgrn_phase(L, P0, P0, P1, P2, p.in[13]);
    SEAM(7);
    if (IN(8)) { pg8::Gemm g{H, (const bf16_t*)(ws + WS_WINB) + (size_t)6144 * 1024, T_, 2048, 1024}; pg8::StaticOrder S; S.init(T_, 2048, G, bx); EpiGate E{P0};
                 pg8::gemm_phase<EpiGate, pg8::StaticOrder>(L, g, S, E, nullptr); }
    SEAM(8);
    if (IN(9)) { pg8::Gemm g{P0, (const bf16_t*)(ws + WS_WOUTB), T_, 1024, 2048}; pg8::StaticOrder S; S.init(T_, 1024, G, bx); EpiDelta<true> E{D0, H, mod + 16 * 3072 + 2048};
                 pg8::gemm_phase<EpiDelta<true>, pg8::StaticOrder>(L, g, S, E, nullptr); }
    SEAM(9);
    if (IN(10)) final_norm_phase(x, H, p.out, p.in[15]);
#undef IN
#undef SEAM
}

extern "C" void kernel_launch(void* const* d_in, const int* in_sizes, int n_in, void* d_out, int out_size, void* d_ws, size_t ws_size, hipStream_t stream) {
    static int grid_blocks = 0;
    if (!grid_blocks) {
        if (n_in != 16 || ws_size < WS_END) { fprintf(stderr, "kernel_launch: need 16 inputs and >= %zu bytes of workspace; got %d, %zu\n", (size_t)WS_END, n_in, ws_size); grid_blocks = -1; return; }
        int dev = 0, cus = 0, per_cu = 0;
        hipGetDevice(&dev);
        hipDeviceGetAttribute(&cus, hipDeviceAttributeMultiprocessorCount, dev);
        if (hipFuncSetAttribute((const void*)mega_fwd, hipFuncAttributeMaxDynamicSharedMemorySize, LDS_BYTES) != hipSuccess) { fprintf(stderr, "kernel_launch: hipFuncSetAttribute failed\n"); }
        if (hipOccupancyMaxActiveBlocksPerMultiprocessor(&per_cu, (const void*)mega_fwd, 512, LDS_BYTES) != hipSuccess || per_cu < 1) { fprintf(stderr, "kernel_launch: occupancy query failed (%d)\n", per_cu); per_cu = 1; }
        (void)hipGetLastError();
        grid_blocks = cus * per_cu;
        if (grid_blocks > 256) grid_blocks = 256;
    }
    if (grid_blocks < 0) return;
    if (hipMemsetAsync((char*)d_ws + WS_BAR, 0, XCD_BAR_WORDS * sizeof(unsigned), stream) != hipSuccess) { fprintf(stderr, "kernel_launch: memset of barrier words failed\n"); return; }
    Params p{};
    for (int i = 0; i < 16; ++i) p.in[i] = (const float*)d_in[i];
    p.out = (float*)d_out; p.ws = (unsigned char*)d_ws;
    p.ph_lo = 0; p.ph_hi = NPHASE;
    void* args[] = {&p};
    hipError_t e = hipLaunchCooperativeKernel((const void*)mega_fwd, dim3(grid_blocks), dim3(512), args, LDS_BYTES, stream);
    if (e != hipSuccess) fprintf(stderr, "cooperative launch failed: %s (grid %d)\n", hipGetErrorString(e), grid_blocks);
}
```
